# Optimizing an MI355X kernel written in HIP

```python
import math
import jax, jax.numpy as jnp
from jax import lax
import numpy as np


D_MODEL = 1024
BATCH = 16
SEQ = 4096
DEPTH = 1

ATTN_HEADS = 8
QK_NOPE_DIM = 64
QK_ROPE_DIM = 32
V_HEAD_DIM = 64
Q_LORA_RANK = 256
KV_LORA_RANK = 128
ATTN_WIDTH = ATTN_HEADS * V_HEAD_DIM
ROPE_THETA = 10000.0
Q_BLOCK = 128

HY_WIDTH = D_MODEL - ATTN_WIDTH
HY_ORDER = 2
HY_GROUPS = 8
HY_SHORT = 3
HY_EMB_DIM = 33
HY_FILTER_HIDDEN = 64
HY_FAST_DECAY = 0.3
HY_SLOW_DECAY = 1.5
HY_TARGET = 1e-2

OFF_CQ = Q_LORA_RANK
OFF_CKV = OFF_CQ + KV_LORA_RANK
OFF_KR = OFF_CKV + QK_ROPE_DIM
IN_WIDTH = OFF_KR + (HY_ORDER + 1) * HY_WIDTH

PEER_HEADS = 8
PEER_NKEYS = 128
PEER_N_EXPERTS = PEER_NKEYS * PEER_NKEYS
PEER_DK = 128
PEER_TOPK = 16
PEER_CHUNK = 128

ALPHA = (2 * DEPTH) ** 0.25
BETA = (8 * DEPTH) ** -0.25
LN_EPS = 1e-5
RMS_EPS = 1e-6

kernel_name = "hymba_mla_hyena_peer_deepnorm_encoder"


def layer_norm(x, g, b):
    xf = x.astype(jnp.float32)
    mu = jnp.mean(xf, axis=-1, keepdims=True)
    var = jnp.mean(jnp.square(xf - mu), axis=-1, keepdims=True)
    return ((xf - mu) * lax.rsqrt(var + LN_EPS) * g.astype(jnp.float32) + b.astype(jnp.float32)).astype(x.dtype)


def rms_norm(x, g):
    xf = x.astype(jnp.float32)
    y = xf * lax.rsqrt(jnp.mean(jnp.square(xf), axis=-1, keepdims=True) + RMS_EPS)
    return (y * g.astype(jnp.float32)).astype(x.dtype)


def rotary_tables(L, dim):
    inv = 1.0 / (ROPE_THETA ** (jnp.arange(0, dim, 2, dtype=jnp.float32) / dim))
    ang = jnp.arange(L, dtype=jnp.float32)[:, None] * inv[None, :]
    return jnp.cos(ang), jnp.sin(ang)


def apply_rope(x, cos, sin):
    half = x.shape[-1] // 2
    xf = x.astype(jnp.float32)
    x1, x2 = xf[..., :half], xf[..., half:]
    return jnp.concatenate([x1 * cos - x2 * sin, x1 * sin + x2 * cos], axis=-1).astype(x.dtype)


def mla_attention(c_q, c_kv, k_rope, q_norm_g, w_uq, kv_norm_g, w_ukv):
    B, S, _ = c_q.shape
    q = (rms_norm(c_q, q_norm_g) @ w_uq).reshape(B, S, ATTN_HEADS, QK_NOPE_DIM + QK_ROPE_DIM)
    kv = (rms_norm(c_kv, kv_norm_g) @ w_ukv).reshape(B, S, ATTN_HEADS, QK_NOPE_DIM + V_HEAD_DIM)
    q_nope, q_pe = q[..., :QK_NOPE_DIM], q[..., QK_NOPE_DIM:]
    k_nope, v = kv[..., :QK_NOPE_DIM], kv[..., QK_NOPE_DIM:]
    cos, sin = rotary_tables(S, QK_ROPE_DIM)
    q_pe = apply_rope(q_pe, cos[:, None, :], sin[:, None, :])
    k_pe = apply_rope(k_rope, cos, sin)
    scale = (QK_NOPE_DIM + QK_ROPE_DIM) ** -0.5
    nb = S // Q_BLOCK
    qn_blocks = q_nope.reshape(B, nb, Q_BLOCK, ATTN_HEADS, QK_NOPE_DIM).transpose(1, 0, 2, 3, 4)
    qr_blocks = q_pe.reshape(B, nb, Q_BLOCK, ATTN_HEADS, QK_ROPE_DIM).transpose(1, 0, 2, 3, 4)

    def one_block(qs):
        qn, qr = qs
        s = (jnp.einsum('bqhd,bkhd->bhqk', qn, k_nope, preferred_element_type=jnp.float32)
             + jnp.einsum('bqhr,bkr->bhqk', qr, k_pe, preferred_element_type=jnp.float32)) * scale
        p = jax.nn.softmax(s, axis=-1)
        return jnp.einsum('bhqk,bkhd->bqhd', p.astype(v.dtype), v)

    o = lax.map(one_block, (qn_blocks, qr_blocks))
    return o.transpose(1, 0, 2, 3, 4).reshape(B, S, ATTN_HEADS, V_HEAD_DIM)


def short_conv(u, w, b):
    L = u.shape[1]
    pad = HY_SHORT // 2
    up = jnp.pad(u, ((0, 0), (pad, pad), (0, 0)))
    y = b
    for i in range(HY_SHORT):
        y = y + up[:, i:i + L] * w[i]
    return y


def hyena_position_features(L):
    t = jnp.linspace(0.0, 1.0, L, dtype=jnp.float32)[:, None]
    bands = (HY_EMB_DIM - 1) // 2
    w = 2.0 * math.pi * jnp.arange(L, dtype=jnp.float32) / L
    f = jnp.linspace(1e-4, bands - 1, bands, dtype=jnp.float32)
    ang = w[:, None] * f[None, :]
    return t, jnp.concatenate([t, jnp.cos(ang), -jnp.sin(ang)], axis=-1)


def hyena_filters(L, w1, b1, fr1, w2, b2, fr2, w3):
    f32 = jnp.float32
    t, z = hyena_position_features(L)
    h = jnp.sin(fr1.astype(f32) * (z @ w1.astype(f32) + b1.astype(f32)))
    h = jnp.sin(fr2.astype(f32) * (h @ w2.astype(f32) + b2.astype(f32)))
    h = (h @ w3.astype(f32)).reshape(L, HY_ORDER, 2, HY_WIDTH)
    max_decay = math.log(HY_TARGET) / HY_FAST_DECAY
    min_decay = math.log(HY_TARGET) / HY_SLOW_DECAY
    deltas = jnp.linspace(min_decay, max_decay, HY_WIDTH, dtype=f32)
    decay = jnp.exp(-t * jnp.abs(deltas)[None, :])
    h = h * decay[:, None, None, :]
    return h / (jnp.sum(jnp.abs(h), axis=0, keepdims=True) + 1e-6)


def hyena_mixer(u, short_w, short_b, w1, b1, fr1, w2, b2, fr2, w3, hy_bias):
    B, L, _ = u.shape
    n = 2 * L
    u = short_conv(u, short_w, short_b)
    v = u[..., :HY_WIDTH]
    gates = (u[..., HY_WIDTH:2 * HY_WIDTH], u[..., 2 * HY_WIDTH:])
    h = hyena_filters(L, w1, b1, fr1, w2, b2, fr2, w3)
    hf = jnp.fft.rfft(h, n=n, axis=0)
    h_bidir = hf[:, :, 0] + jnp.conj(hf[:, :, 1])
    z = v
    for o in range(HY_ORDER):
        zf = jnp.fft.rfft(z.astype(jnp.float32), n=n, axis=1)
        y = jnp.fft.irfft(zf * h_bidir[None, :, o], n=n, axis=1)[:, :L]
        z = gates[o] * (y.astype(z.dtype) + hy_bias[o] * z)
    return z


def peer_ffn(x, w_q, sub_keys, u_tab, v_tab):
    B, S, D = x.shape
    T = B * S
    xt = x.reshape(T // PEER_CHUNK, PEER_CHUNK, D)

    def chunk(xc):
        C = xc.shape[0]
        q = (xc @ w_q).reshape(C, PEER_HEADS, 2, PEER_DK // 2)
        s = jnp.einsum('chpd,hpnd->chpn', q, sub_keys, preferred_element_type=jnp.float32)
        sv, si = lax.top_k(s, PEER_TOPK)
        cand = sv[:, :, 0, :, None] + sv[:, :, 1, None, :]
        cidx = si[:, :, 0, :, None] * PEER_NKEYS + si[:, :, 1, None, :]
        cand = cand.reshape(C, PEER_HEADS, PEER_TOPK * PEER_TOPK)
        cidx = cidx.reshape(C, PEER_HEADS, PEER_TOPK * PEER_TOPK)
        best, pos = lax.top_k(cand, PEER_TOPK)
        eidx = jnp.take_along_axis(cidx, pos, axis=-1)
        g = jax.nn.softmax(best, axis=-1)
        u = u_tab[eidx]
        a = jax.nn.gelu(jnp.einsum('chkd,cd->chk', u, xc, preferred_element_type=jnp.float32), approximate=False)
        vv = v_tab[eidx]
        return jnp.einsum('chk,chkd->cd', (g * a).astype(vv.dtype), vv)

    return lax.map(chunk, xt).reshape(B, S, D)


def setup_inputs(seed: int = 0) -> dict:
    key = jax.random.key(seed)
    ks = jax.random.split(key, 32)
    f32 = jnp.float32

    def nrm(k, shape, scale):
        return jax.random.normal(k, shape, f32) * scale

    def gain(k, shape):
        return 1.0 + 0.02 * jax.random.normal(k, shape, f32)

    L_ = DEPTH
    return {
        "x": jax.random.normal(ks[0], (BATCH, SEQ, D_MODEL), f32),
        "emb_ln_g": gain(ks[1], (D_MODEL,)),
        "emb_ln_b": nrm(ks[2], (D_MODEL,), 0.02),
        "w_in": nrm(ks[3], (L_, D_MODEL, IN_WIDTH), D_MODEL ** -0.5),
        "q_norm_g": gain(ks[4], (L_, Q_LORA_RANK)),
        "w_uq": nrm(ks[5], (L_, Q_LORA_RANK, ATTN_HEADS * (QK_NOPE_DIM + QK_ROPE_DIM)), Q_LORA_RANK ** -0.5),
        "kv_norm_g": gain(ks[6], (L_, KV_LORA_RANK)),
        "w_ukv": nrm(ks[7], (L_, KV_LORA_RANK, ATTN_HEADS * (QK_NOPE_DIM + V_HEAD_DIM)), KV_LORA_RANK ** -0.5),
        "hy_short_w": nrm(ks[8], (L_, HY_SHORT, (HY_ORDER + 1) * HY_WIDTH), HY_SHORT ** -0.5),
        "hy_short_b": nrm(ks[9], (L_, (HY_ORDER + 1) * HY_WIDTH), 0.02),
        "hy_filt_w1": nrm(ks[10], (L_, HY_EMB_DIM, HY_FILTER_HIDDEN), HY_EMB_DIM ** -0.5),
        "hy_filt_b1": nrm(ks[11], (L_, HY_FILTER_HIDDEN), 0.02),
        "hy_filt_freq1": gain(ks[12], (L_, HY_FILTER_HIDDEN)),
        "hy_filt_w2": nrm(ks[13], (L_, HY_FILTER_HIDDEN, HY_FILTER_HIDDEN), HY_FILTER_HIDDEN ** -0.5),
        "hy_filt_b2": nrm(ks[14], (L_, HY_FILTER_HIDDEN), 0.02),
        "hy_filt_freq2": gain(ks[15], (L_, HY_FILTER_HIDDEN)),
        "hy_filt_w3": nrm(ks[16], (L_, HY_FILTER_HIDDEN, HY_ORDER * 2 * HY_WIDTH), HY_FILTER_HIDDEN ** -0.5),
        "hy_bias": nrm(ks[17], (L_, HY_ORDER, HY_WIDTH), 0.5),
        "attn_out_g": gain(ks[18], (L_, ATTN_WIDTH)),
        "hy_out_g": gain(ks[19], (L_, HY_WIDTH)),
        "w_o": nrm(ks[20], (L_, ATTN_WIDTH + HY_WIDTH, D_MODEL), BETA * (ATTN_WIDTH + HY_WIDTH) ** -0.5),
        "ln_mix_g": gain(ks[21], (L_, D_MODEL)),
        "ln_mix_b": nrm(ks[22], (L_, D_MODEL), 0.02),
        "peer_wq": nrm(ks[23], (L_, D_MODEL, PEER_HEADS * PEER_DK), D_MODEL ** -0.5),
        "peer_sub_keys": nrm(ks[24], (L_, PEER_HEADS, 2, PEER_NKEYS, PEER_DK // 2), (PEER_DK // 2) ** -0.5),
        "peer_u": nrm(ks[25], (L_, PEER_N_EXPERTS, D_MODEL), D_MODEL ** -0.5),
        "peer_v": nrm(ks[26], (L_, PEER_N_EXPERTS, D_MODEL), BETA * PEER_HEADS ** -0.5),
        "ln_ffn_g": gain(ks[27], (L_, D_MODEL)),
        "ln_ffn_b": nrm(ks[28], (L_, D_MODEL), 0.02),
    }


def reference(x, emb_ln_g, emb_ln_b, w_in, q_norm_g, w_uq, kv_norm_g, w_ukv,
              hy_short_w, hy_short_b, hy_filt_w1, hy_filt_b1, hy_filt_freq1,
              hy_filt_w2, hy_filt_b2, hy_filt_freq2, hy_filt_w3, hy_bias,
              attn_out_g, hy_out_g, w_o, ln_mix_g, ln_mix_b,
              peer_wq, peer_sub_keys, peer_u, peer_v, ln_ffn_g, ln_ffn_b):
    B, S, _ = x.shape
    h = layer_norm(x, emb_ln_g, emb_ln_b)
    for l in range(DEPTH):
        proj = h @ w_in[l]
        c_q = proj[..., :OFF_CQ]
        c_kv = proj[..., OFF_CQ:OFF_CKV]
        k_rope = proj[..., OFF_CKV:OFF_KR]
        hy_in = proj[..., OFF_KR:]
        a = mla_attention(c_q, c_kv, k_rope, q_norm_g[l], w_uq[l], kv_norm_g[l], w_ukv[l])
        a = rms_norm(a, attn_out_g[l].reshape(ATTN_HEADS, V_HEAD_DIM)).reshape(B, S, ATTN_WIDTH)
        y = hyena_mixer(hy_in, hy_short_w[l], hy_short_b[l], hy_filt_w1[l], hy_filt_b1[l], hy_filt_freq1[l],
                        hy_filt_w2[l], hy_filt_b2[l], hy_filt_freq2[l], hy_filt_w3[l], hy_bias[l])
        gw = HY_WIDTH // HY_GROUPS
        y = rms_norm(y.reshape(B, S, HY_GROUPS, gw), hy_out_g[l].reshape(HY_GROUPS, gw)).reshape(B, S, HY_WIDTH)
        mix = jnp.concatenate([a, y], axis=-1) @ w_o[l]
        h = layer_norm(ALPHA * h + mix, ln_mix_g[l], ln_mix_b[l])
        f = peer_ffn(h, peer_wq[l], peer_sub_keys[l], peer_u[l], peer_v[l])
        h = layer_norm(ALPHA * h + f, ln_ffn_g[l], ln_ffn_b[l])
    return h
```

```cpp
#include <hip/hip_runtime.h>
#include <hip/hip_bf16.h>
#include <hip/hip_cooperative_groups.h>
#include <cstdio>
#include <cstdint>
namespace cg = cooperative_groups;

#ifndef MULTI_LAUNCH
#define MULTI_LAUNCH 0
#define DBG_PHASE -1
#define DBG_OFF WS_YT
#define DBG_N16 ((size_t)16 * 512 * 4096)
#endif

typedef unsigned short u16;
using bf16x8 = __attribute__((ext_vector_type(8))) short;
using bf16x2 = __attribute__((ext_vector_type(2))) __bf16;
using f32x16 = __attribute__((ext_vector_type(16))) float;
using f32x4 = __attribute__((ext_vector_type(4))) float;
using u32x4 = __attribute__((ext_vector_type(4))) unsigned;
using u32x2 = __attribute__((ext_vector_type(2))) unsigned;
using f32x2 = __attribute__((ext_vector_type(2))) float;

#define HD __host__ __device__ __forceinline__
#define DEV __device__ __forceinline__

constexpr int DM = 1024, NB = 16, SEQ = 4096, NT = NB * SEQ;
constexpr int INW = 1952, PLD = 2048, OFF_CQ = 256, OFF_CKV = 384, OFF_KR = 416;
constexpr int HYW = 512;
constexpr float ALPHA = 1.189207115002721f;
constexpr float LN_EPS = 1e-5f, RMS_EPS = 1e-6f;
constexpr int NTHREADS = 256;
constexpr int LDS_CTRL_OFF = 67584;
constexpr int LDS_BYTES = LDS_CTRL_OFF + 256;

constexpr size_t MiB = 1ull << 20;
constexpr size_t WS_HB = 0;
constexpr size_t WS_RA = 128 * MiB;
constexpr size_t WS_QRAW = WS_RA;
constexpr size_t WS_KN = WS_RA + 96 * MiB;
constexpr size_t WS_VT = WS_RA + 160 * MiB;
constexpr size_t WS_MIX = WS_RA;
constexpr size_t WS_PQ = WS_RA + 128 * MiB;
constexpr size_t WS_CQN = 384 * MiB;
constexpr size_t WS_CKVN = 416 * MiB;
constexpr size_t WS_KPE = 432 * MiB;
constexpr size_t WS_HYT = 440 * MiB;
constexpr size_t WS_CAT = WS_HYT;
constexpr size_t WS_H2B = WS_HYT;
constexpr size_t WS_EIDX = WS_HYT + 128 * MiB;
constexpr size_t WS_GATE = WS_HYT + 160 * MiB;
constexpr size_t WS_YT = 632 * MiB;
constexpr size_t WS_KSPEC = 696 * MiB;
constexpr size_t WS_KC = 760 * MiB;
constexpr size_t WS_UB = 792 * MiB;
constexpr size_t WS_VB = 824 * MiB;
constexpr size_t WS_WIN = 856 * MiB;
constexpr size_t WS_WUQ = 860 * MiB;
constexpr size_t WS_WUKV = 861 * MiB;
constexpr size_t WS_WO = 862 * MiB;
constexpr size_t WS_WQ = 864 * MiB;
constexpr size_t WS_SUBK = 866 * MiB;
constexpr size_t WS_HID2 = 867 * MiB;
constexpr size_t WS_ROPE = 868 * MiB;
constexpr size_t WS_END = 870 * MiB;
constexpr size_t WS_CTRL = WS_END;
constexpr size_t CTRL_BAR_OFF = 65536;
constexpr size_t CTRL_BYTES = CTRL_BAR_OFF + 3456 * 4;

struct Params {
  const float* in[29];
  float* out;
  char* ws;
};
enum { I_X = 0, I_EMB_G, I_EMB_B, I_WIN, I_QNG, I_WUQ, I_KVNG, I_WUKV, I_SHW, I_SHB, I_FW1, I_FB1, I_FFR1, I_FW2, I_FB2, I_FFR2, I_FW3, I_HYB,
       I_AOG, I_HOG, I_WO, I_LNMG, I_LNMB, I_PWQ, I_PSK, I_PU, I_PV, I_LNFG, I_LNFB };

DEV u16 f2bf(float f) { unsigned u = __float_as_uint(f); u += 0x7fffu + ((u >> 16) & 1u); return (u16)(u >> 16); }
DEV float bf2f(u16 h) { return __uint_as_float(((unsigned)h) << 16); }
DEV unsigned pack2(float lo, float hi) { return (unsigned)f2bf(lo) | ((unsigned)f2bf(hi) << 16); }
DEV float bflo(unsigned w) { return __uint_as_float(w << 16); }
DEV float bfhi(unsigned w) { return __uint_as_float(w & 0xffff0000u); }
DEV float wave_sum(float v) {
#pragma unroll
  for (int o = 32; o >= 1; o >>= 1) v += __shfl_xor(v, o);
  return v;
}
DEV float dot2bf(unsigned a, unsigned b, float acc) {
  return __builtin_amdgcn_fdot2_f32_bf16(__builtin_bit_cast(bf16x2, a), __builtin_bit_cast(bf16x2, b), acc, false);
}
DEV int crow(int r, int hi) { return (r & 3) + 8 * (r >> 2) + 4 * hi; }
#define LGKM0() asm volatile("s_waitcnt lgkmcnt(0)" ::: "memory")

DEV unsigned xcc_id() { return (unsigned)__builtin_amdgcn_s_getreg(20 | (3 << 11)) & 0xfu; }
DEV unsigned cu_key() { return ((unsigned)__builtin_amdgcn_s_getreg(63492) >> 8) & 0xffu; }
DEV int next_item(int* q, char* smem) {
  int* shw = (int*)(smem + LDS_CTRL_OFF);
  __syncthreads();
  if (threadIdx.x == 0) shw[1] = atomicAdd(q, 1);
  __syncthreads();
  return shw[1];
}
DEV void fft_seam(int* flags, char* smem, bool leader) {
  int* shw = (int*)(smem + LDS_CTRL_OFF);
  __syncthreads();
  if (threadIdx.x == 0) {
    const int key = shw[2];
    if (leader) { __threadfence(); atomicExch(flags + key, 1); }
    else { while (atomicAdd(flags + key, 0) == 0) __builtin_amdgcn_s_sleep(64); }
  }
  __syncthreads();
}
static constexpr float kCos32[32] = {1.000000000e+00f, 9.807852804e-01f, 9.238795325e-01f, 8.314696123e-01f, 7.071067812e-01f, 5.555702330e-01f, 3.826834324e-01f, 1.950903220e-01f, 0.0f, -1.950903220e-01f, -3.826834324e-01f, -5.555702330e-01f, -7.071067812e-01f, -8.314696123e-01f, -9.238795325e-01f, -9.807852804e-01f, -1.000000000e+00f, -9.807852804e-01f, -9.238795325e-01f, -8.314696123e-01f, -7.071067812e-01f, -5.555702330e-01f, -3.826834324e-01f, -1.950903220e-01f, 0.0f, 1.950903220e-01f, 3.826834324e-01f, 5.555702330e-01f, 7.071067812e-01f, 8.314696123e-01f, 9.238795325e-01f, 9.807852804e-01f};
static constexpr float kSin32[32] = {0.000000000e+00f, 1.950903220e-01f, 3.826834324e-01f, 5.555702330e-01f, 7.071067812e-01f, 8.314696123e-01f, 9.238795325e-01f, 9.807852804e-01f, 1.000000000e+00f, 9.807852804e-01f, 9.238795325e-01f, 8.314696123e-01f, 7.071067812e-01f, 5.555702330e-01f, 3.826834324e-01f, 1.950903220e-01f, 0.0f, -1.950903220e-01f, -3.826834324e-01f, -5.555702330e-01f, -7.071067812e-01f, -8.314696123e-01f, -9.238795325e-01f, -9.807852804e-01f, -1.000000000e+00f, -9.807852804e-01f, -9.238795325e-01f, -8.314696123e-01f, -7.071067812e-01f, -5.555702330e-01f, -3.826834324e-01f, -1.950903220e-01f};

struct cf2 { float x, y; };
HD int PADI(int i) { return i + (i >> 5); }
DEV int PADL(int i) { return PADI(i); }
constexpr int FFT_N = 8192;

template <int R> struct Log2 { static constexpr int v = 1 + Log2<R / 2>::v; };
template <> struct Log2<1> { static constexpr int v = 0; };
template <int R> HD constexpr int bitrev_c(int r) {
  int o = 0;
  for (int b = 0; b < Log2<R>::v; ++b) o |= ((r >> b) & 1) << (Log2<R>::v - 1 - b);
  return o;
}
template <int R> DEV void dft_regs(float (&re)[R], float (&im)[R]) {
#pragma unroll
  for (int ls = Log2<R>::v - 1; ls >= 0; --ls) {
    const int s = 1 << ls;
#pragma unroll
    for (int i = 0; i < R; ++i) {
      if ((i & s) == 0) {
        const int j = i + s;
        const int tw = (i & (s - 1)) * (R / (2 * s)) * (32 / R);
        const float ar = re[i], ai = im[i], br = re[j], bi = im[j];
        re[i] = ar + br; im[i] = ai + bi;
        const float dr = ar - br, di = ai - bi;
        const float c = kCos32[tw], sn = kSin32[tw];
        re[j] = dr * c + di * sn;
        im[j] = di * c - dr * sn;
      }
    }
  }
}
DEV void twiddle1(int lo, int Ncur, float& c, float& s) {
  const float a = 2.0f * (float)lo / (float)Ncur;
  c = cospif(a); s = -sinpif(a);
}
template <int R> DEV void fft_pass_fwd(cf2* X, int unit, int q, int Ncur) {
  const int lo = unit & (q - 1), seg = unit / q, base = seg * Ncur + lo;
  float re[R], im[R];
#pragma unroll
  for (int j = 0; j < R; ++j) { cf2 v = X[PADL(base + j * q)]; re[j] = v.x; im[j] = v.y; }
  dft_regs<R>(re, im);
  if (q > 1) {
    float c1, s1; twiddle1(lo, Ncur, c1, s1);
    float wr = 1.f, wi = 0.f;
#pragma unroll
    for (int r = 1; r < R; ++r) {
      const float nwr = wr * c1 - wi * s1, nwi = wr * s1 + wi * c1; wr = nwr; wi = nwi;
      const int k = bitrev_c<R>(r);
      const float xr = re[k], xi = im[k];
      re[k] = xr * wr - xi * wi; im[k] = xr * wi + xi * wr;
    }
  }
#pragma unroll
  for (int r = 0; r < R; ++r) { cf2 v; v.x = re[bitrev_c<R>(r)]; v.y = im[bitrev_c<R>(r)]; X[PADL(base + r * q)] = v; }
}
template <int R> DEV void fft_pass_inv(cf2* X, int unit, int q, int Ncur) {
  const int lo = unit & (q - 1), seg = unit / q, base = seg * Ncur + lo;
  float re[R], im[R];
#pragma unroll
  for (int r = 0; r < R; ++r) { cf2 v = X[PADL(base + r * q)]; re[r] = v.x; im[r] = v.y; }
  if (q > 1) {
    float c1, s1; twiddle1(lo, Ncur, c1, s1); s1 = -s1;
    float wr = 1.f, wi = 0.f;
#pragma unroll
    for (int r = 1; r < R; ++r) {
      const float nwr = wr * c1 - wi * s1, nwi = wr * s1 + wi * c1; wr = nwr; wi = nwi;
      const float xr = re[r], xi = im[r];
      re[r] = xr * wr - xi * wi; im[r] = xr * wi + xi * wr;
    }
  }
#pragma unroll
  for (int r = 0; r < R; ++r) im[r] = -im[r];
  dft_regs<R>(re, im);
#pragma unroll
  for (int j = 0; j < R; ++j) { cf2 v; v.x = re[bitrev_c<R>(j)]; v.y = -im[bitrev_c<R>(j)]; X[PADL(base + j * q)] = v; }
}
DEV void fft_fwd_block(cf2* X) {
  int tid = threadIdx.x;
  asm volatile("" : "+v"(tid));
#pragma unroll 1
  for (int u = tid; u < 512; u += 256) fft_pass_fwd<16>(X, u, 512, 8192);
  __syncthreads();
#pragma unroll 1
  for (int u = tid; u < 512; u += 256) fft_pass_fwd<16>(X, u, 32, 512);
  __syncthreads();
  fft_pass_fwd<32>(X, tid, 1, 32);
  __syncthreads();
}
DEV void fft_inv_block(cf2* X) {
  int tid = threadIdx.x;
  asm volatile("" : "+v"(tid));
  fft_pass_inv<32>(X, tid, 1, 32);
  __syncthreads();
#pragma unroll 1
  for (int u = tid; u < 512; u += 256) fft_pass_inv<16>(X, u, 32, 512);
  __syncthreads();
#pragma unroll 1
  for (int u = tid; u < 512; u += 256) fft_pass_inv<16>(X, u, 512, 8192);
  __syncthreads();
}

DEV void fft_mid_fused(cf2* X, int tid, const cf2* __restrict__ ks) {
  const int base = tid * 32;
  float re[32], im[32];
#pragma unroll
  for (int j = 0; j < 32; ++j) { cf2 v = X[PADL(base + j)]; re[j] = v.x; im[j] = v.y; }
  f32x4 kk[16];
#pragma unroll
  for (int r = 0; r < 16; ++r) kk[r] = *reinterpret_cast<const f32x4*>(ks + base + 2 * r);
  dft_regs<32>(re, im);
  float re2[32], im2[32];
#pragma unroll
  for (int r = 0; r < 32; ++r) {
    const int idx = bitrev_c<32>(r);
    const float kx = kk[r >> 1][(r & 1) * 2], ky = kk[r >> 1][(r & 1) * 2 + 1];
    const float xr = re[idx], xi = im[idx];
    re2[r] = xr * kx - xi * ky; im2[r] = -(xr * ky + xi * kx);
  }
  dft_regs<32>(re2, im2);
#pragma unroll
  for (int j = 0; j < 32; ++j) { cf2 v; v.x = re2[bitrev_c<32>(j)]; v.y = -im2[bitrev_c<32>(j)]; X[PADL(base + j)] = v; }
}
DEV void fft_conv_block(cf2* X, const cf2* __restrict__ ks) {
  int tid = threadIdx.x;
  asm volatile("" : "+v"(tid));
#pragma unroll 1
  for (int u = tid; u < 512; u += 256) fft_pass_fwd<16>(X, u, 512, 8192);
  __syncthreads();
#pragma unroll 1
  for (int u = tid; u < 512; u += 256) fft_pass_fwd<16>(X, u, 32, 512);
  __syncthreads();
  fft_mid_fused(X, tid, ks);
  __syncthreads();
#pragma unroll 1
  for (int u = tid; u < 512; u += 256) fft_pass_inv<16>(X, u, 32, 512);
  __syncthreads();
#pragma unroll 1
  for (int u = tid; u < 512; u += 256) fft_pass_inv<16>(X, u, 512, 8192);
  __syncthreads();
}

constexpr int GLD = 72;
DEV void store_wave_tile(const f32x16& a00, const f32x16& a01, const f32x16& a10, const f32x16& a11, u16* Cw, u16* dst, int ldc, int ncols_valid) {
  const int lane = threadIdx.x & 63, r32 = lane & 31, hi = lane >> 5;
#pragma unroll
  for (int r = 0; r < 16; ++r) {
    const int row = crow(r, hi);
    Cw[row * GLD + r32] = f2bf(a00[r]);
    Cw[row * GLD + 32 + r32] = f2bf(a01[r]);
    Cw[(32 + row) * GLD + r32] = f2bf(a10[r]);
    Cw[(32 + row) * GLD + 32 + r32] = f2bf(a11[r]);
  }
  LGKM0();
#pragma unroll
  for (int t = 0; t < 8; ++t) {
    const int id = lane + 64 * t, row = id >> 3, cc = id & 7;
    const u32x4 v = *reinterpret_cast<const u32x4*>(Cw + row * GLD + cc * 8);
    if (cc * 8 < ncols_valid) *reinterpret_cast<u32x4*>(dst + (size_t)row * ldc + cc * 8) = v;
  }
  LGKM0();
}
struct EpiBf16 {
  u16* C; int ldc; int N;
  DEV void store(const f32x16& a00, const f32x16& a01, const f32x16& a10, const f32x16& a11, int m0, int n0, int wm, int wn, u16* Cw) const {
    const int c0 = n0 + wn * 64;
    store_wave_tile(a00, a01, a10, a11, Cw, C + (size_t)(m0 + wm * 64) * ldc + c0, ldc, N - c0);
  }
  DEV void operator()(int row0, int col, float v0, float v1, float v2, float v3) const {
    if (col < N) {
      u16* p = C + (size_t)row0 * ldc + col;
      p[0] = f2bf(v0); p[ldc] = f2bf(v1); p[2 * ldc] = f2bf(v2); p[3 * ldc] = f2bf(v3);
    }
  }
};
struct EpiKV {
  u16* kn; u16* vt;
  DEV void store(const f32x16& a00, const f32x16& a01, const f32x16& a10, const f32x16& a11, int m0, int n0, int wm, int wn, u16* Cw) const {
    if (wn == 0) {
      store_wave_tile(a00, a01, a10, a11, Cw, kn + (size_t)(m0 + wm * 64) * 512 + (n0 >> 7) * 64, 512, 64);
    } else {
      const int lane = threadIdx.x & 63, r32 = lane & 31, hi = lane >> 5;
      const int rbase = m0 + wm * 64 + 4 * hi, cbase = n0 + 64 + r32;
#pragma unroll
      for (int g = 0; g < 4; ++g) {
        (*this)(rbase + 8 * g, cbase, a00[4 * g], a00[4 * g + 1], a00[4 * g + 2], a00[4 * g + 3]);
        (*this)(rbase + 8 * g, cbase + 32, a01[4 * g], a01[4 * g + 1], a01[4 * g + 2], a01[4 * g + 3]);
        (*this)(rbase + 32 + 8 * g, cbase, a10[4 * g], a10[4 * g + 1], a10[4 * g + 2], a10[4 * g + 3]);
        (*this)(rbase + 32 + 8 * g, cbase + 32, a11[4 * g], a11[4 * g + 1], a11[4 * g + 2], a11[4 * g + 3]);
      }
    }
  }
  DEV void operator()(int row0, int col, float v0, float v1, float v2, float v3) const {
    const int h = col >> 7, j = col & 127;
    if (j < 64) {
      u16* p = kn + (size_t)row0 * 512 + h * 64 + j;
      p[0] = f2bf(v0); p[512] = f2bf(v1); p[1024] = f2bf(v2); p[1536] = f2bf(v3);
    } else {
      const int b = row0 >> 12, s = row0 & 4095;
      u16* p = vt + ((size_t)((b * 8 + h) * 64 + (j - 64))) * 4096 + s;
      u32x2 w = {pack2(v0, v1), pack2(v2, v3)};
      *reinterpret_cast<u32x2*>(p) = w;
    }
  }
};

template <class Epi>
DEV void gemm_tile(const u16* __restrict__ A, int lda, const u16* __restrict__ Bt, int ldb, int N, int K, int m0, int n0, const Epi& epi, char* smem) {
  u16* As = (u16*)smem; u16* Bs = As + 128 * GLD;
  const int tid = threadIdx.x, lane = tid & 63, w = tid >> 6, wm = w >> 1, wn = w & 1, r32 = lane & 31, hi = lane >> 5;
  const int srow = tid >> 3, scc = tid & 7;
  f32x16 acc00 = {}, acc01 = {}, acc10 = {}, acc11 = {};
  u32x4 ra0[4], rb0[4], ra1[4], rb1[4];
  const u16* Ag = A + (size_t)(m0 + srow) * lda + scc * 8;
  const u16* Bg = Bt + (size_t)(n0 + srow) * ldb + scc * 8;
#define GLOAD(RA, RB, KOFF) do { _Pragma("unroll") for (int i = 0; i < 4; ++i) {                                   \
    RA[i] = *reinterpret_cast<const u32x4*>(Ag + (size_t)(32 * i) * lda + (KOFF));                                    \
    RB[i] = (n0 + srow + 32 * i < N) ? *reinterpret_cast<const u32x4*>(Bg + (size_t)(32 * i) * ldb + (KOFF)) : u32x4{0, 0, 0, 0}; } } while (0)
#define SWRITE(RA, RB) do { _Pragma("unroll") for (int i = 0; i < 4; ++i) {                                          \
    *reinterpret_cast<u32x4*>(As + (srow + 32 * i) * GLD + scc * 8) = RA[i];                                          \
    *reinterpret_cast<u32x4*>(Bs + (srow + 32 * i) * GLD + scc * 8) = RB[i]; } } while (0)
#define COMPUTE() do { _Pragma("unroll") for (int kk = 0; kk < 4; ++kk) {                                            \
    const bf16x8 a0 = *reinterpret_cast<const bf16x8*>(As + (wm * 64 + r32) * GLD + kk * 16 + hi * 8);               \
    const bf16x8 a1 = *reinterpret_cast<const bf16x8*>(As + (wm * 64 + 32 + r32) * GLD + kk * 16 + hi * 8);          \
    const bf16x8 b0 = *reinterpret_cast<const bf16x8*>(Bs + (wn * 64 + r32) * GLD + kk * 16 + hi * 8);               \
    const bf16x8 b1 = *reinterpret_cast<const bf16x8*>(Bs + (wn * 64 + 32 + r32) * GLD + kk * 16 + hi * 8);          \
    acc00 = __builtin_amdgcn_mfma_f32_32x32x16_bf16(a0, b0, acc00, 0, 0, 0);                                          \
    acc01 = __builtin_amdgcn_mfma_f32_32x32x16_bf16(a0, b1, acc01, 0, 0, 0);                                          \
    acc10 = __builtin_amdgcn_mfma_f32_32x32x16_bf16(a1, b0, acc10, 0, 0, 0);                                          \
    acc11 = __builtin_amdgcn_mfma_f32_32x32x16_bf16(a1, b1, acc11, 0, 0, 0); } } while (0)
  GLOAD(ra0, rb0, 0);
  GLOAD(ra1, rb1, 64);
  for (int k0 = 0; k0 < K; k0 += 128) {
    __syncthreads();
    SWRITE(ra0, rb0);
    __syncthreads();
    if (k0 + 128 < K) GLOAD(ra0, rb0, k0 + 128);
    COMPUTE();
    __syncthreads();
    SWRITE(ra1, rb1);
    __syncthreads();
    if (k0 + 192 < K) GLOAD(ra1, rb1, k0 + 192);
    COMPUTE();
  }
#undef GLOAD
#undef SWRITE
#undef COMPUTE
  __syncthreads();
  epi.store(acc00, acc01, acc10, acc11, m0, n0, wm, wn, (u16*)smem + w * (64 * GLD));
}

template <int NR>
DEV void ln_x_rows(const Params& p, int row0) {
  const int lane = threadIdx.x & 63;
  f32x4 v[NR][4];
#pragma unroll
  for (int r = 0; r < NR; ++r) {
    const float* x = p.in[I_X] + (size_t)(row0 + r) * DM;
#pragma unroll
    for (int i = 0; i < 4; ++i) v[r][i] = *reinterpret_cast<const f32x4*>(x + i * 256 + lane * 4);
  }
  float mu[NR], rstd[NR];
#pragma unroll
  for (int r = 0; r < NR; ++r) {
    float s = 0;
#pragma unroll
    for (int i = 0; i < 4; ++i) s += v[r][i][0] + v[r][i][1] + v[r][i][2] + v[r][i][3];
    mu[r] = wave_sum(s) * (1.f / DM);
  }
#pragma unroll
  for (int r = 0; r < NR; ++r) {
    float ss = 0;
#pragma unroll
    for (int i = 0; i < 4; ++i) { for (int j = 0; j < 4; ++j) { const float d = v[r][i][j] - mu[r]; ss += d * d; } }
    rstd[r] = rsqrtf(wave_sum(ss) * (1.f / DM) + LN_EPS);
  }
#pragma unroll
  for (int i = 0; i < 4; ++i) {
    const int c = i * 256 + lane * 4;
    const f32x4 g = *reinterpret_cast<const f32x4*>(p.in[I_EMB_G] + c), b = *reinterpret_cast<const f32x4*>(p.in[I_EMB_B] + c);
#pragma unroll
    for (int r = 0; r < NR; ++r) {
      u16* hb = (u16*)(p.ws + WS_HB) + (size_t)(row0 + r) * DM;
      u32x2 o = {pack2((v[r][i][0] - mu[r]) * rstd[r] * g[0] + b[0], (v[r][i][1] - mu[r]) * rstd[r] * g[1] + b[1]),
                 pack2((v[r][i][2] - mu[r]) * rstd[r] * g[2] + b[2], (v[r][i][3] - mu[r]) * rstd[r] * g[3] + b[3])};
      *reinterpret_cast<u32x2*>(hb + c) = o;
    }
  }
}
DEV void transpose_cvt(const float* __restrict__ in, u16* __restrict__ out, int K, int N, int gtid, int gsize) {
  const int total = (K >> 6) * N;
  for (int idx = gtid; idx < total; idx += gsize) {
    const int kg = idx / N, n = idx - kg * N;
    const float* src = in + (size_t)(kg * 64) * N + n;
    u16* dst = out + (size_t)n * K + kg * 64;
#pragma unroll
    for (int c = 0; c < 8; ++c) {
      float v[8];
#pragma unroll
      for (int j = 0; j < 8; ++j) v[j] = src[(size_t)(c * 8 + j) * N];
      *reinterpret_cast<u32x4*>(dst + c * 8) = u32x4{pack2(v[0], v[1]), pack2(v[2], v[3]), pack2(v[4], v[5]), pack2(v[6], v[7])};
    }
  }
}
DEV void cvt_bf16(const float* __restrict__ in, u16* __restrict__ out, size_t n8, size_t gtid, size_t gsize) {
  for (size_t i = gtid; i < n8; i += gsize) {
    const f32x4 a = *reinterpret_cast<const f32x4*>(in + i * 8), b = *reinterpret_cast<const f32x4*>(in + i * 8 + 4);
    u32x4 o = {pack2(a[0], a[1]), pack2(a[2], a[3]), pack2(b[0], b[1]), pack2(b[2], b[3])};
    *reinterpret_cast<u32x4*>(out + i * 8) = o;
  }
}
DEV void cvt_fp8(const float* __restrict__ in, unsigned char* __restrict__ out, size_t n16, float scale, size_t gtid, size_t gsize) {
  for (size_t i = gtid; i < n16; i += gsize) {
    unsigned w[4];
#pragma unroll
    for (int c = 0; c < 4; ++c) {
      const f32x4 a = *reinterpret_cast<const f32x4*>(in + i * 16 + c * 4);
      int t = __builtin_amdgcn_cvt_pk_fp8_f32(a[0] * scale, a[1] * scale, 0, false);
      t = __builtin_amdgcn_cvt_pk_fp8_f32(a[2] * scale, a[3] * scale, t, true);
      w[c] = (unsigned)t;
    }
    *reinterpret_cast<u32x4*>(out + i * 16) = u32x4{w[0], w[1], w[2], w[3]};
  }
}
DEV void hy_hidden(const Params& p, int l) {
  const int lane = threadIdx.x & 63;
  const float t = (float)l / 4095.0f;
  const float wl = 6.283185307179586f * (float)l / 4096.0f;
  const int j = lane & 15;
  const float fj = 1e-4f + (float)j * ((15.0f - 1e-4f) / 15.0f);
  const float ang = wl * fj;
  const float zc = cosf(ang), zs = -sinf(ang);
  const float* w1 = p.in[I_FW1];
  float pre = p.in[I_FB1][lane] + t * w1[lane];
#pragma unroll
  for (int jj = 0; jj < 16; ++jj) {
    pre += __shfl(zc, jj) * w1[(1 + jj) * 64 + lane];
    pre += __shfl(zs, jj) * w1[(17 + jj) * 64 + lane];
  }
  const float h1 = sinf(p.in[I_FFR1][lane] * pre);
  const float* w2 = p.in[I_FW2];
  float pre2 = p.in[I_FB2][lane];
#pragma unroll 8
  for (int k = 0; k < 64; ++k) pre2 += __shfl(h1, k) * w2[k * 64 + lane];
  const float h2 = sinf(p.in[I_FFR2][lane] * pre2);
  ((float*)(p.ws + WS_HID2))[l * 64 + lane] = h2;
}
DEV void rope_table(const Params& p, int gtid, int gsize) {
  float* ct = (float*)(p.ws + WS_ROPE); float* st = ct + 4096 * 16;
  for (int idx = gtid; idx < 4096 * 16; idx += gsize) {
    const int s = idx >> 4, i = idx & 15;
    const float inv = 1.0f / powf(10000.0f, (float)(2 * i) / 32.0f);
    const float ang = (float)s * inv;
    ct[idx] = cosf(ang); st[idx] = sinf(ang);
  }
}

DEV void filter_build(const Params& p, int item, char* smem) {
  const int o = item >> 9, c = item & 511, tid = threadIdx.x;
  const int nf = (o * 2 + 0) * 512 + c, nb = (o * 2 + 1) * 512 + c;
  const float* w3 = p.in[I_FW3];
  const float* hid2 = (const float*)(p.ws + WS_HID2);
  float* red = (float*)smem;
  const float min_decay = -3.0701134573253945f, max_decay = -15.350567286626973f;
  const float delta = fabsf(min_decay + (float)c * ((max_decay - min_decay) / 511.0f));
  float hf[16], hb[16];
#pragma unroll
  for (int i = 0; i < 16; ++i) { hf[i] = 0.f; hb[i] = 0.f; }
#pragma unroll 1
  for (int k4 = 0; k4 < 16; ++k4) {
    float wf[4], wb[4];
#pragma unroll
    for (int j = 0; j < 4; ++j) { wf[j] = w3[(k4 * 4 + j) * 2048 + nf]; wb[j] = w3[(k4 * 4 + j) * 2048 + nb]; }
#pragma unroll
    for (int i = 0; i < 16; ++i) {
      const f32x4 hv = *reinterpret_cast<const f32x4*>(hid2 + (tid + 256 * i) * 64 + k4 * 4);
#pragma unroll
      for (int j = 0; j < 4; ++j) { hf[i] += hv[j] * wf[j]; hb[i] += hv[j] * wb[j]; }
    }
  }
  float sf = 0, sb = 0;
#pragma unroll
  for (int i = 0; i < 16; ++i) {
    const int l = tid + 256 * i;
    const float dec = expf(-((float)l / 4095.0f) * delta);
    hf[i] *= dec; hb[i] *= dec;
    sf += fabsf(hf[i]); sb += fabsf(hb[i]);
  }
  sf = wave_sum(sf); sb = wave_sum(sb);
  __syncthreads();
  if ((tid & 63) == 0) { red[(tid >> 6) * 2] = sf; red[(tid >> 6) * 2 + 1] = sb; }
  __syncthreads();
  const float tf = red[0] + red[2] + red[4] + red[6], tb = red[1] + red[3] + red[5] + red[7];
  const float nf_ = 1.0f / (tf + 1e-6f), nb_ = 1.0f / (tb + 1e-6f);
  float* kc = (float*)(p.ws + WS_KC) + (size_t)item * 8192;
#pragma unroll
  for (int i = 0; i < 16; ++i) {
    const int l = tid + 256 * i;
    const float f = hf[i] * nf_, b = hb[i] * nb_;
    if (l == 0) { kc[0] = f + b; kc[4096] = 0.f; }
    else { kc[l] = f; kc[8192 - l] = b; }
  }
}

DEV void token_norms(const Params& p, int t) {
  const int lane = threadIdx.x & 63;
  const u16* pr = (const u16*)(p.ws + WS_RA) + (size_t)t * PLD;
  {
    const u32x2 w = *reinterpret_cast<const u32x2*>(pr + lane * 4);
    const float v0 = bflo(w[0]), v1 = bfhi(w[0]), v2 = bflo(w[1]), v3 = bfhi(w[1]);
    const float r = rsqrtf(wave_sum(v0 * v0 + v1 * v1 + v2 * v2 + v3 * v3) * (1.f / 256.f) + RMS_EPS);
    const f32x4 g = *reinterpret_cast<const f32x4*>(p.in[I_QNG] + lane * 4);
    u32x2 o = {pack2(v0 * r * g[0], v1 * r * g[1]), pack2(v2 * r * g[2], v3 * r * g[3])};
    *reinterpret_cast<u32x2*>((u16*)(p.ws + WS_CQN) + (size_t)t * 256 + lane * 4) = o;
  }
  {
    const unsigned w = *reinterpret_cast<const unsigned*>(pr + OFF_CQ + lane * 2);
    const float v0 = bflo(w), v1 = bfhi(w);
    const float r = rsqrtf(wave_sum(v0 * v0 + v1 * v1) * (1.f / 128.f) + RMS_EPS);
    const float g0 = p.in[I_KVNG][lane * 2], g1 = p.in[I_KVNG][lane * 2 + 1];
    *reinterpret_cast<unsigned*>((u16*)(p.ws + WS_CKVN) + (size_t)t * 128 + lane * 2) = pack2(v0 * r * g0, v1 * r * g1);
  }
  if (lane < 16) {
    const float x1 = bf2f(pr[OFF_CKV + lane]), x2 = bf2f(pr[OFF_CKV + 16 + lane]);
    const int s = t & 4095;
    const float* ct = (const float*)(p.ws + WS_ROPE);
    const float c = ct[s * 16 + lane], sn = ct[4096 * 16 + s * 16 + lane];
    u16* kp = (u16*)(p.ws + WS_KPE) + (size_t)t * 32;
    kp[lane] = f2bf(x1 * c - x2 * sn); kp[16 + lane] = f2bf(x1 * sn + x2 * c);
  }
}
DEV void shortconv_tile(const Params& p, int item, char* smem) {
  const int cb = item % 24, tb = (item / 24) & 63, b = item / (24 * 64);
  const int tid = threadIdx.x, t0 = tb * 64;
  float* tile = (float*)smem;
  const u16* pr = (const u16*)(p.ws + WS_RA);
  __syncthreads();
  for (int ch = tid; ch < 66 * 8; ch += 256) {
    const int row = ch >> 3, cc = ch & 7, t = t0 - 1 + row;
    u32x4 w = {0, 0, 0, 0};
    if (t >= 0 && t < SEQ) w = *reinterpret_cast<const u32x4*>(pr + (size_t)(b * SEQ + t) * PLD + OFF_KR + cb * 64 + cc * 8);
    float* d = tile + row * 65 + cc * 8;
#pragma unroll
    for (int j = 0; j < 4; ++j) { d[2 * j] = bflo(w[j]); d[2 * j + 1] = bfhi(w[j]); }
  }
  __syncthreads();
  const int c = tid >> 2, tq = (tid & 3) * 16, chn = cb * 64 + c;
  const float* sw = p.in[I_SHW];
  const float w0 = sw[chn], w1 = sw[1536 + chn], w2 = sw[3072 + chn], bias = p.in[I_SHB][chn];
  unsigned o[8];
#pragma unroll
  for (int j = 0; j < 8; ++j) {
    const int ta = tq + 2 * j;
    const float y0 = bias + w0 * tile[ta * 65 + c] + w1 * tile[(ta + 1) * 65 + c] + w2 * tile[(ta + 2) * 65 + c];
    const float y1 = bias + w0 * tile[(ta + 1) * 65 + c] + w1 * tile[(ta + 2) * 65 + c] + w2 * tile[(ta + 3) * 65 + c];
    o[j] = pack2(y0, y1);
  }
  u16* dst = (u16*)(p.ws + WS_HYT) + ((size_t)(b * 1536 + chn)) * SEQ + t0 + tq;
  *reinterpret_cast<u32x4*>(dst) = u32x4{o[0], o[1], o[2], o[3]};
  *reinterpret_cast<u32x4*>(dst + 8) = u32x4{o[4], o[5], o[6], o[7]};
}
DEV void kspec_item(const Params& p, int item, char* smem) {
  cf2* X = (cf2*)smem;
  const int tid = threadIdx.x;
  const float* kc = (const float*)(p.ws + WS_KC) + (size_t)item * 8192;
  __syncthreads();
  for (int i = tid; i < 8192; i += 256) { cf2 v; v.x = kc[i]; v.y = 0.f; X[PADI(i)] = v; }
  __syncthreads();
  fft_fwd_block(X);
  cf2* ks = (cf2*)(p.ws + WS_KSPEC) + (size_t)item * 8192;
  for (int i = tid; i < 8192; i += 256) { cf2 v = X[PADI(i)]; v.x *= (1.f / 8192.f); v.y *= (1.f / 8192.f); ks[i] = v; }
}

template <int O>
DEV void hyena_conv_round(const Params& p, cf2* X, int c, int b0, int b1, float* scr) {
  const int tid = threadIdx.x;
  const u16* hyT = (const u16*)(p.ws + WS_HYT);
  const cf2* ks = (const cf2*)(p.ws + WS_KSPEC) + ((size_t)(O * 512 + c)) * 8192;
  fft_conv_block(X, ks);
  const float bias = p.in[I_HYB][O * 512 + c];
  const u16* g0p = hyT + ((size_t)(b0 * 1536 + (O + 1) * 512 + c)) * SEQ;
  const u16* g1p = hyT + ((size_t)(b1 * 1536 + (O + 1) * 512 + c)) * SEQ;
  const u16* v0p = hyT + ((size_t)(b0 * 1536 + c)) * SEQ;
  const u16* v1p = hyT + ((size_t)(b1 * 1536 + c)) * SEQ;
  u16* yT = (u16*)(p.ws + WS_YT);
  u16* y0p = yT + ((size_t)(b0 * 512 + c)) * SEQ;
  u16* y1p = yT + ((size_t)(b1 * 512 + c)) * SEQ;
#pragma unroll 4
  for (int i = 0; i < 8; ++i) {
    const int t = i * 512 + tid * 2;
    const unsigned ga = *reinterpret_cast<const unsigned*>(g0p + t), gb = *reinterpret_cast<const unsigned*>(g1p + t);
    const cf2 ya = X[PADI(t)], yb = X[PADI(t + 1)];
    f32x4 zp;
    if constexpr (O == 0) {
      const unsigned a = *reinterpret_cast<const unsigned*>(v0p + t), bq = *reinterpret_cast<const unsigned*>(v1p + t);
      zp[0] = bflo(a); zp[1] = bflo(bq); zp[2] = bfhi(a); zp[3] = bfhi(bq);
    } else {
      zp = *reinterpret_cast<const f32x4*>(scr + 2 * t);
    }
    f32x4 zn;
    zn[0] = bflo(ga) * (ya.x + bias * zp[0]);
    zn[1] = bflo(gb) * (ya.y + bias * zp[1]);
    zn[2] = bfhi(ga) * (yb.x + bias * zp[2]);
    zn[3] = bfhi(gb) * (yb.y + bias * zp[3]);
    if constexpr (O == 0) {
      *reinterpret_cast<f32x4*>(scr + 2 * t) = zn;
      cf2 e0; e0.x = zn[0]; e0.y = zn[1]; X[PADI(t)] = e0;
      cf2 e1; e1.x = zn[2]; e1.y = zn[3]; X[PADI(t + 1)] = e1;
      cf2 zz; zz.x = 0.f; zz.y = 0.f; X[PADI(4096 + t)] = zz; X[PADI(4096 + t + 1)] = zz;
    } else {
      *reinterpret_cast<unsigned*>(y0p + t) = pack2(zn[0], zn[2]);
      *reinterpret_cast<unsigned*>(y1p + t) = pack2(zn[1], zn[3]);
    }
  }
  __syncthreads();
}
DEV void hyena_conv_item(const Params& p, int item, char* smem) {
  cf2* X = (cf2*)smem;
  const int tid = threadIdx.x, c = item >> 3, bp = item & 7, b0 = bp * 2, b1 = bp * 2 + 1;
  const u16* hyT = (const u16*)(p.ws + WS_HYT);
  const u16* v0p = hyT + ((size_t)(b0 * 1536 + c)) * SEQ;
  const u16* v1p = hyT + ((size_t)(b1 * 1536 + c)) * SEQ;
  float* scr = (float*)(p.ws + WS_KC) + (size_t)blockIdx.x * 8192;
  __syncthreads();
#pragma unroll 4
  for (int i = 0; i < 8; ++i) {
    const int t = i * 512 + tid * 2;
    const unsigned a = *reinterpret_cast<const unsigned*>(v0p + t), bq = *reinterpret_cast<const unsigned*>(v1p + t);
    cf2 e0; e0.x = bflo(a); e0.y = bflo(bq); X[PADI(t)] = e0;
    cf2 e1; e1.x = bfhi(a); e1.y = bfhi(bq); X[PADI(t + 1)] = e1;
    cf2 zz; zz.x = 0.f; zz.y = 0.f; X[PADI(4096 + t)] = zz; X[PADI(4096 + t + 1)] = zz;
  }
  __syncthreads();
  hyena_conv_round<0>(p, X, c, b0, b1, scr);
  hyena_conv_round<1>(p, X, c, b0, b1, scr);
}

constexpr int KLD = 104, VLD = 72;
DEV unsigned cvtpk(float lo, float hi) { unsigned r; asm volatile("v_cvt_pk_bf16_f32 %0, %1, %2" : "=v"(r) : "v"(lo), "v"(hi)); return r; }
DEV void attention_item(const Params& p, int item, char* smem) {
  const int qb = item & 31, h = (item >> 5) & 7, b = item >> 8;
  const int tid = threadIdx.x, lane = tid & 63, w = tid >> 6, r32 = lane & 31, hi = lane >> 5;
  u16* Ks = (u16*)smem; u16* Vs = Ks + 64 * KLD;
  float* wsf = (float*)(Vs + 64 * VLD) + w * 32;
  const u16* qraw = (const u16*)(p.ws + WS_QRAW);
  const u16* kn = (const u16*)(p.ws + WS_KN);
  const u16* kpe = (const u16*)(p.ws + WS_KPE);
  const u16* vt = (const u16*)(p.ws + WS_VT) + ((size_t)((b * 8 + h) * 64)) * SEQ;
  constexpr float SC = 0.10206207261596577f * 1.4426950408889634f;
  const int tq = qb * 128 + w * 32 + r32;
  bf16x8 qr[6];
  {
    const u16* qp = qraw + ((size_t)(b * SEQ + tq)) * 768 + h * 96 + hi * 8;
#pragma unroll
    for (int d0 = 0; d0 < 6; ++d0) qr[d0] = *reinterpret_cast<const bf16x8*>(qp + d0 * 16);
    const float* ct = (const float*)(p.ws + WS_ROPE) + tq * 16 + hi * 8;
    const float* st = ct + 4096 * 16;
#pragma unroll
    for (int j = 0; j < 8; ++j) {
      const float x1 = bf2f((u16)qr[4][j]), x2 = bf2f((u16)qr[5][j]);
      const float c = ct[j], sn = st[j];
      qr[4][j] = (short)f2bf(x1 * c - x2 * sn);
      qr[5][j] = (short)f2bf(x1 * sn + x2 * c);
    }
  }
  f32x16 o0 = {}, o1 = {};
  float m_reg = -1e30f, l_reg = 0.f;
  const u16* ksrc[3]; int kstep[3], kdst[3];
#pragma unroll
  for (int i = 0; i < 3; ++i) {
    const int ch = tid + 256 * i, key = ch / 12, cc = ch - key * 12;
    const size_t tk = (size_t)(b * SEQ + key);
    ksrc[i] = (cc < 8) ? (kn + tk * 512 + h * 64 + cc * 8) : (kpe + tk * 32 + (cc - 8) * 8);
    kstep[i] = (cc < 8) ? 64 * 512 : 64 * 32;
    kdst[i] = key * KLD + cc * 8;
  }
  const u16* vsrc[2]; int vdst[2];
#pragma unroll
  for (int i = 0; i < 2; ++i) {
    const int ch = tid + 256 * i, dv = ch >> 3, cc = ch & 7;
    vsrc[i] = vt + (size_t)dv * SEQ + cc * 8;
    vdst[i] = dv * VLD + cc * 8;
  }
  u32x4 kreg[3], vreg[2];
#pragma unroll
  for (int i = 0; i < 3; ++i) kreg[i] = *reinterpret_cast<const u32x4*>(ksrc[i]);
#pragma unroll
  for (int i = 0; i < 2; ++i) vreg[i] = *reinterpret_cast<const u32x4*>(vsrc[i]);
  for (int k0 = 0; k0 < SEQ; k0 += 64) {
    __syncthreads();
#pragma unroll
    for (int i = 0; i < 3; ++i) *reinterpret_cast<u32x4*>(Ks + kdst[i]) = kreg[i];
#pragma unroll
    for (int i = 0; i < 2; ++i) *reinterpret_cast<u32x4*>(Vs + vdst[i]) = vreg[i];
    __syncthreads();
    if (k0 + 64 < SEQ) {
#pragma unroll
      for (int i = 0; i < 3; ++i) { ksrc[i] += kstep[i]; kreg[i] = *reinterpret_cast<const u32x4*>(ksrc[i]); }
#pragma unroll
      for (int i = 0; i < 2; ++i) { vsrc[i] += 64; vreg[i] = *reinterpret_cast<const u32x4*>(vsrc[i]); }
    }
    f32x16 p0 = {}, p1 = {};
    __builtin_amdgcn_s_setprio(1);
#pragma unroll
    for (int d0 = 0; d0 < 6; ++d0) {
      const bf16x8 k0f = *reinterpret_cast<const bf16x8*>(Ks + r32 * KLD + d0 * 16 + hi * 8);
      const bf16x8 k1f = *reinterpret_cast<const bf16x8*>(Ks + (32 + r32) * KLD + d0 * 16 + hi * 8);
      p0 = __builtin_amdgcn_mfma_f32_32x32x16_bf16(k0f, qr[d0], p0, 0, 0, 0);
      p1 = __builtin_amdgcn_mfma_f32_32x32x16_bf16(k1f, qr[d0], p1, 0, 0, 0);
    }
    __builtin_amdgcn_s_setprio(0);
    float pmax = p0[0];
#pragma unroll
    for (int r = 1; r < 16; ++r) pmax = fmaxf(pmax, p0[r]);
#pragma unroll
    for (int r = 0; r < 16; ++r) pmax = fmaxf(pmax, p1[r]);
    { const auto rr = __builtin_amdgcn_permlane32_swap(__float_as_uint(pmax), __float_as_uint(pmax), false, false);
      pmax = fmaxf(__uint_as_float(rr[0]), __uint_as_float(rr[1])); }
    const float mn = fmaxf(m_reg, pmax);
    const float alpha = __builtin_amdgcn_exp2f((m_reg - mn) * SC);
    m_reg = mn;
    const float mnC = -mn * SC;
    float ps = 0.f;
#pragma unroll
    for (int r = 0; r < 16; ++r) { p0[r] = __builtin_amdgcn_exp2f(fmaf(p0[r], SC, mnC)); ps += p0[r]; }
#pragma unroll
    for (int r = 0; r < 16; ++r) { p1[r] = __builtin_amdgcn_exp2f(fmaf(p1[r], SC, mnC)); ps += p1[r]; }
    l_reg = l_reg * alpha + ps;
    if (__any(alpha < 1.f)) {
      if (hi == 0) wsf[r32] = alpha;
      LGKM0();
#pragma unroll
      for (int r = 0; r < 16; ++r) { const float a = wsf[crow(r, hi)]; o0[r] *= a; o1[r] *= a; }
    }
    bf16x8 pa0, pa1, pa2, pa3;
#define PK4(P, BASE, OUT) do { unsigned a0 = cvtpk(P[BASE + 0], P[BASE + 1]), a1 = cvtpk(P[BASE + 2], P[BASE + 3]);   \
    unsigned b0 = cvtpk(P[BASE + 4], P[BASE + 5]), b1 = cvtpk(P[BASE + 6], P[BASE + 7]);                              \
    auto r0 = __builtin_amdgcn_permlane32_swap(a0, b0, false, false); auto r1 = __builtin_amdgcn_permlane32_swap(a1, b1, false, false); \
    u32x4 wv = {r0[0], r1[0], r0[1], r1[1]}; OUT = *reinterpret_cast<bf16x8*>(&wv); } while (0)
    PK4(p0, 0, pa0); PK4(p0, 8, pa1); PK4(p1, 0, pa2); PK4(p1, 8, pa3);
#undef PK4
    {
      const u16* vb0 = Vs + r32 * VLD + hi * 8;
      const u16* vb1 = Vs + (32 + r32) * VLD + hi * 8;
      __builtin_amdgcn_s_setprio(1);
      o0 = __builtin_amdgcn_mfma_f32_32x32x16_bf16(pa0, *reinterpret_cast<const bf16x8*>(vb0), o0, 0, 0, 0);
      o1 = __builtin_amdgcn_mfma_f32_32x32x16_bf16(pa0, *reinterpret_cast<const bf16x8*>(vb1), o1, 0, 0, 0);
      o0 = __builtin_amdgcn_mfma_f32_32x32x16_bf16(pa1, *reinterpret_cast<const bf16x8*>(vb0 + 16), o0, 0, 0, 0);
      o1 = __builtin_amdgcn_mfma_f32_32x32x16_bf16(pa1, *reinterpret_cast<const bf16x8*>(vb1 + 16), o1, 0, 0, 0);
      o0 = __builtin_amdgcn_mfma_f32_32x32x16_bf16(pa2, *reinterpret_cast<const bf16x8*>(vb0 + 32), o0, 0, 0, 0);
      o1 = __builtin_amdgcn_mfma_f32_32x32x16_bf16(pa2, *reinterpret_cast<const bf16x8*>(vb1 + 32), o1, 0, 0, 0);
      o0 = __builtin_amdgcn_mfma_f32_32x32x16_bf16(pa3, *reinterpret_cast<const bf16x8*>(vb0 + 48), o0, 0, 0, 0);
      o1 = __builtin_amdgcn_mfma_f32_32x32x16_bf16(pa3, *reinterpret_cast<const bf16x8*>(vb1 + 48), o1, 0, 0, 0);
      __builtin_amdgcn_s_setprio(0);
    }
    LGKM0();
  }
  l_reg += __shfl_xor(l_reg, 32);
  if (hi == 0) wsf[r32] = l_reg;
  LGKM0();
  const float g0 = p.in[I_AOG][h * 64 + r32], g1 = p.in[I_AOG][h * 64 + 32 + r32];
  u16* cat = (u16*)(p.ws + WS_CAT);
#pragma unroll
  for (int r = 0; r < 16; ++r) {
    const int row = crow(r, hi);
    const float il = 1.0f / wsf[row];
    const float a0 = o0[r] * il, a1 = o1[r] * il;
    float ss = a0 * a0 + a1 * a1;
#pragma unroll
    for (int off = 16; off >= 1; off >>= 1) ss += __shfl_xor(ss, off);
    const float rs = rsqrtf(ss * (1.f / 64.f) + RMS_EPS);
    u16* dst = cat + ((size_t)(b * SEQ + qb * 128 + w * 32 + row)) * 1024 + h * 64;
    dst[r32] = f2bf(a0 * rs * g0);
    dst[32 + r32] = f2bf(a1 * rs * g1);
  }
  LGKM0();
}
DEV void hyout_tile(const Params& p, int item, char* smem) {
  const int g = item & 7, tb = (item >> 3) & 63, b = item >> 9;
  const int tid = threadIdx.x, t0 = tb * 64;
  float* tile = (float*)smem;
  const u16* yT = (const u16*)(p.ws + WS_YT);
  __syncthreads();
#pragma unroll
  for (int i = 0; i < 2; ++i) {
    const int ch = tid + 256 * i, c = ch >> 3, cc = ch & 7;
    const u32x4 w = *reinterpret_cast<const u32x4*>(yT + ((size_t)(b * 512 + g * 64 + c)) * SEQ + t0 + cc * 8);
    float* d = tile + c * 65 + cc * 8;
#pragma unroll
    for (int j = 0; j < 4; ++j) { d[2 * j] = bflo(w[j]); d[2 * j + 1] = bfhi(w[j]); }
  }
  __syncthreads();
  const int t = tid >> 2, cq = (tid & 3) * 16;
  float v[16]; float ss = 0;
#pragma unroll
  for (int j = 0; j < 16; ++j) { v[j] = tile[(cq + j) * 65 + t]; ss += v[j] * v[j]; }
  ss += __shfl_xor(ss, 1); ss += __shfl_xor(ss, 2);
  const float rs = rsqrtf(ss * (1.f / 64.f) + RMS_EPS);
  const float* gg = p.in[I_HOG] + g * 64 + cq;
  unsigned o[8];
#pragma unroll
  for (int j = 0; j < 8; ++j) o[j] = pack2(v[2 * j] * rs * gg[2 * j], v[2 * j + 1] * rs * gg[2 * j + 1]);
  u16* dst = (u16*)(p.ws + WS_CAT) + ((size_t)(b * SEQ + t0 + t)) * 1024 + 512 + g * 64 + cq;
  *reinterpret_cast<u32x4*>(dst) = u32x4{o[0], o[1], o[2], o[3]};
  *reinterpret_cast<u32x4*>(dst + 8) = u32x4{o[4], o[5], o[6], o[7]};
}

template <int NR>
DEV void ln_mix_rows(const Params& p, int row0) {
  const int lane = threadIdx.x & 63;
  float v[NR][16];
#pragma unroll
  for (int r = 0; r < NR; ++r) {
    const u16* hb = (const u16*)(p.ws + WS_HB) + (size_t)(row0 + r) * DM;
    const u16* mx = (const u16*)(p.ws + WS_MIX) + (size_t)(row0 + r) * DM;
#pragma unroll
    for (int i = 0; i < 2; ++i) {
      const int c = (i * 64 + lane) * 8;
      const u32x4 a = *reinterpret_cast<const u32x4*>(hb + c), m = *reinterpret_cast<const u32x4*>(mx + c);
#pragma unroll
      for (int j = 0; j < 4; ++j) { v[r][i * 8 + 2 * j] = ALPHA * bflo(a[j]) + bflo(m[j]); v[r][i * 8 + 2 * j + 1] = ALPHA * bfhi(a[j]) + bfhi(m[j]); }
    }
  }
  float mu[NR], rstd[NR];
#pragma unroll
  for (int r = 0; r < NR; ++r) {
    float s = 0;
#pragma unroll
    for (int j = 0; j < 16; ++j) s += v[r][j];
    mu[r] = wave_sum(s) * (1.f / DM);
  }
#pragma unroll
  for (int r = 0; r < NR; ++r) {
    float ss = 0;
#pragma unroll
    for (int j = 0; j < 16; ++j) { const float d = v[r][j] - mu[r]; ss += d * d; }
    rstd[r] = rsqrtf(wave_sum(ss) * (1.f / DM) + LN_EPS);
  }
#pragma unroll
  for (int i = 0; i < 2; ++i) {
    const int c = (i * 64 + lane) * 8;
    const float* g = p.in[I_LNMG] + c; const float* bb = p.in[I_LNMB] + c;
#pragma unroll
    for (int r = 0; r < NR; ++r) {
      u16* h2 = (u16*)(p.ws + WS_H2B) + (size_t)(row0 + r) * DM;
      unsigned o[4];
#pragma unroll
      for (int j = 0; j < 4; ++j) o[j] = pack2((v[r][i * 8 + 2 * j] - mu[r]) * rstd[r] * g[2 * j] + bb[2 * j], (v[r][i * 8 + 2 * j + 1] - mu[r]) * rstd[r] * g[2 * j + 1] + bb[2 * j + 1]);
      *reinterpret_cast<u32x4*>(h2 + c) = u32x4{o[0], o[1], o[2], o[3]};
    }
  }
}

constexpr int SC_LD = 353, SC_PP = 176, SC_PT = 40;
constexpr int TV_LD = 33, TI_LD = 36;
DEV void routing_group(const Params& p, int item, char* smem) {
  const int hg = item & 1, tt = item >> 1, t0 = tt * 32;
  const int tid = threadIdx.x, lane = tid & 63, w = tid >> 6, r32 = lane & 31, hi = lane >> 5;
  float* sc = (float*)smem;
  float* topv = sc + 32 * SC_LD;
  unsigned char* topi = (unsigned char*)(topv + 4 * 32 * TV_LD);
  const u16* pq = (const u16*)(p.ws + WS_PQ);
  const u16* subk = (const u16*)(p.ws + WS_SUBK);
#pragma unroll 1
  for (int hh = 0; hh < 4; ++hh) {
    const int h = hg * 4 + hh;
    __syncthreads();
    {
      const int pp = w >> 1, nt0 = (w & 1) * 2;
      f32x16 a0 = {}, a1 = {};
      const u16* ap = pq + ((size_t)(t0 + r32)) * 1024 + h * 128 + pp * 64 + hi * 8;
      const u16* bp0 = subk + ((size_t)((h * 2 + pp) * 128 + nt0 * 32 + r32)) * 64 + hi * 8;
      const u16* bp1 = bp0 + 32 * 64;
#pragma unroll
      for (int kk = 0; kk < 4; ++kk) {
        const bf16x8 a = *reinterpret_cast<const bf16x8*>(ap + kk * 16);
        const bf16x8 b0 = *reinterpret_cast<const bf16x8*>(bp0 + kk * 16);
        const bf16x8 b1 = *reinterpret_cast<const bf16x8*>(bp1 + kk * 16);
        a0 = __builtin_amdgcn_mfma_f32_32x32x16_bf16(a, b0, a0, 0, 0, 0);
        a1 = __builtin_amdgcn_mfma_f32_32x32x16_bf16(a, b1, a1, 0, 0, 0);
      }
#pragma unroll
      for (int r = 0; r < 16; ++r) {
        const int tok = crow(r, hi);
        sc[tok * SC_LD + pp * SC_PP + nt0 * SC_PT + r32] = a0[r];
        sc[tok * SC_LD + pp * SC_PP + (nt0 + 1) * SC_PT + r32] = a1[r];
      }
    }
    __syncthreads();
    {
      const int tok = w * 8 + (lane & 7), pp = (lane >> 3) & 1, part = lane >> 4;
      float* row = sc + tok * SC_LD + pp * SC_PP;
      float* tv = topv + (hh * 32 + tok) * TV_LD + pp * 16;
      unsigned char* ti = topi + (hh * 32 + tok) * TI_LD + pp * 16;
      for (int rd = 0; rd < 16; ++rd) {
        float bv = -INFINITY; int bi = part * 32;
        float sv[32];
#pragma unroll
        for (int n = 0; n < 32; ++n) sv[n] = row[part * SC_PT + n];
#pragma unroll
        for (int n = 0; n < 32; ++n) { if (sv[n] > bv) { bv = sv[n]; bi = part * 32 + n; } }
#pragma unroll
        for (int off = 16; off <= 32; off <<= 1) {
          const float ov = __shfl_xor(bv, off); const int oi = __shfl_xor(bi, off);
          if (ov > bv || (ov == bv && oi < bi)) { bv = ov; bi = oi; }
        }
        if ((bi >> 5) == part) row[part * SC_PT + (bi & 31)] = -INFINITY;
        if (part == 0) { tv[rd] = bv; ti[rd] = (unsigned char)bi; }
        LGKM0();
      }
    }
  }
  __syncthreads();
  if (tid < 128) {
    const int tok = tid & 31, hh = tid >> 5, h = hg * 4 + hh;
    const float* s0 = topv + (hh * 32 + tok) * TV_LD; const float* s1 = s0 + 16;
    const unsigned char* i0 = topi + (hh * 32 + tok) * TI_LD; const unsigned char* i1 = i0 + 16;
    unsigned long long ptr = 0ull;
    float s0r[16];
#pragma unroll
    for (int i = 0; i < 16; ++i) s0r[i] = s0[i];
    float best[16]; int be[16];
#pragma unroll
    for (int rd = 0; rd < 16; ++rd) {
      float bv = -INFINITY; int bi = 0, bj = 0;
      float s1v[16];
#pragma unroll
      for (int i = 0; i < 16; ++i) s1v[i] = s1[(int)((ptr >> (4 * i)) & 15ull)];
#pragma unroll
      for (int i = 0; i < 16; ++i) {
        const int j = (int)((ptr >> (4 * i)) & 15ull);
        const float v = s0r[i] + s1v[i];
        if (v > bv) { bv = v; bi = i; bj = j; }
      }
      ptr += 1ull << (4 * bi);
      best[rd] = bv; be[rd] = (int)i0[bi] * 128 + (int)i1[bj];
    }
    const float mx = best[0];
    float sum = 0.f;
#pragma unroll
    for (int rd = 0; rd < 16; ++rd) { best[rd] = expf(best[rd] - mx); sum += best[rd]; }
    const float inv = 1.0f / sum;
    int* eo = (int*)(p.ws + WS_EIDX) + ((size_t)(t0 + tok)) * 128 + h * 16;
    float* go = (float*)(p.ws + WS_GATE) + ((size_t)(t0 + tok)) * 128 + h * 16;
#pragma unroll
    for (int c4 = 0; c4 < 4; ++c4) {
      *reinterpret_cast<u32x4*>(eo + c4 * 4) = u32x4{(unsigned)be[c4 * 4], (unsigned)be[c4 * 4 + 1], (unsigned)be[c4 * 4 + 2], (unsigned)be[c4 * 4 + 3]};
      *reinterpret_cast<f32x4*>(go + c4 * 4) = f32x4{best[c4 * 4] * inv, best[c4 * 4 + 1] * inv, best[c4 * 4 + 2] * inv, best[c4 * 4 + 3] * inv};
    }
  }
}

DEV void peer_u(const Params& p, int t) {
  const int tid = threadIdx.x, lane = tid & 63, w = tid >> 6, q = lane & 15, rr = lane >> 4;
  const u16* x = (const u16*)(p.ws + WS_H2B) + (size_t)t * DM;
  const unsigned char* ub = (const unsigned char*)(p.ws + WS_UB);
  float xf[64];
#pragma unroll
  for (int i = 0; i < 4; ++i) {
    const u32x4 a = *reinterpret_cast<const u32x4*>(x + (i * 16 + q) * 16), b = *reinterpret_cast<const u32x4*>(x + (i * 16 + q) * 16 + 8);
#pragma unroll
    for (int j = 0; j < 4; ++j) { xf[i * 16 + 2 * j] = bflo(a[j]); xf[i * 16 + 2 * j + 1] = bfhi(a[j]); xf[i * 16 + 8 + 2 * j] = bflo(b[j]); xf[i * 16 + 8 + 2 * j + 1] = bfhi(b[j]); }
  }
  const int* ei = (const int*)(p.ws + WS_EIDX) + (size_t)t * 128;
  float* gi = (float*)(p.ws + WS_GATE) + (size_t)t * 128;
  const int e_lo = ei[lane], e_hi = ei[64 + lane];
  const float g_lo = gi[lane], g_hi = gi[64 + lane];
#pragma unroll 1
  for (int it = 0; it < 16; ++it) {
    const int k0 = it * 8 + rr, k1 = k0 + 4;
    const int e0 = (it < 8) ? __shfl(e_lo, k0) : __shfl(e_hi, k0 - 64);
    const int e1 = (it < 8) ? __shfl(e_lo, k1) : __shfl(e_hi, k1 - 64);
    const float g0 = (it < 8) ? __shfl(g_lo, k0) : __shfl(g_hi, k0 - 64);
    const float g1 = (it < 8) ? __shfl(g_lo, k1) : __shfl(g_hi, k1 - 64);
    const unsigned char* r0 = ub + (size_t)e0 * DM + q * 16;
    const unsigned char* r1 = ub + (size_t)e1 * DM + q * 16;
    u32x4 u0[4], u1[4];
#pragma unroll
    for (int i = 0; i < 4; ++i) { u0[i] = *reinterpret_cast<const u32x4*>(r0 + i * 256); u1[i] = *reinterpret_cast<const u32x4*>(r1 + i * 256); }
    float a0 = 0.f, a1 = 0.f, c0 = 0.f, c1 = 0.f;
#pragma unroll
    for (int i = 0; i < 4; ++i) {
#pragma unroll
      for (int d = 0; d < 4; ++d) {
        const f32x2 lo0 = __builtin_amdgcn_cvt_pk_f32_fp8((int)u0[i][d], false), hi0 = __builtin_amdgcn_cvt_pk_f32_fp8((int)u0[i][d], true);
        const f32x2 lo1 = __builtin_amdgcn_cvt_pk_f32_fp8((int)u1[i][d], false), hi1 = __builtin_amdgcn_cvt_pk_f32_fp8((int)u1[i][d], true);
        const int xb = i * 16 + d * 4;
        a0 = fmaf(lo0[0], xf[xb], a0); a1 = fmaf(lo0[1], xf[xb + 1], a1); a0 = fmaf(hi0[0], xf[xb + 2], a0); a1 = fmaf(hi0[1], xf[xb + 3], a1);
        c0 = fmaf(lo1[0], xf[xb], c0); c1 = fmaf(lo1[1], xf[xb + 1], c1); c0 = fmaf(hi1[0], xf[xb + 2], c0); c1 = fmaf(hi1[1], xf[xb + 3], c1);
      }
    }
    float a = a0 + a1, c = c0 + c1;
    a += __shfl_xor(a, 1); c += __shfl_xor(c, 1);
    a += __shfl_xor(a, 2); c += __shfl_xor(c, 2);
    a += __shfl_xor(a, 4); c += __shfl_xor(c, 4);
    a += __shfl_xor(a, 8); c += __shfl_xor(c, 8);
    a *= (1.f / 128.f); c *= (1.f / 128.f);
    const float ga = 0.5f * a * (1.0f + erff(a * 0.7071067811865476f));
    const float gc = 0.5f * c * (1.0f + erff(c * 0.7071067811865476f));
    if (q == 0) { gi[k0] = g0 * ga * (1.f / 16.f); gi[k1] = g1 * gc * (1.f / 16.f); }
  }
}
DEV void peer_v(const Params& p, int t) {
  const int lane = threadIdx.x & 63;
  const u16* x = (const u16*)(p.ws + WS_H2B) + (size_t)t * DM;
  const unsigned char* vb = (const unsigned char*)(p.ws + WS_VB);
  const int* ei = (const int*)(p.ws + WS_EIDX) + (size_t)t * 128;
  const float* gi = (const float*)(p.ws + WS_GATE) + (size_t)t * 128;
  const int e_lo = ei[lane], e_hi = ei[64 + lane];
  const float w_lo = gi[lane], w_hi = gi[64 + lane];
  float acc[16];
#pragma unroll
  for (int j = 0; j < 16; ++j) acc[j] = 0.f;
#pragma unroll 1
  for (int k = 0; k < 128; k += 16) {
    u32x4 vv[16]; float wk[16];
#pragma unroll
    for (int kk = 0; kk < 16; ++kk) {
      const int kx = k + kk;
      const int e = (kx < 64) ? __shfl(e_lo, kx) : __shfl(e_hi, kx - 64);
      vv[kk] = *reinterpret_cast<const u32x4*>(vb + (size_t)e * DM + lane * 16);
      wk[kk] = (kx < 64) ? __shfl(w_lo, kx) : __shfl(w_hi, kx - 64);
    }
#pragma unroll
    for (int kk = 0; kk < 16; ++kk) {
#pragma unroll
      for (int d = 0; d < 4; ++d) {
        const f32x2 lo = __builtin_amdgcn_cvt_pk_f32_fp8((int)vv[kk][d], false), hi = __builtin_amdgcn_cvt_pk_f32_fp8((int)vv[kk][d], true);
        acc[d * 4 + 0] = fmaf(wk[kk], lo[0], acc[d * 4 + 0]); acc[d * 4 + 1] = fmaf(wk[kk], lo[1], acc[d * 4 + 1]);
        acc[d * 4 + 2] = fmaf(wk[kk], hi[0], acc[d * 4 + 2]); acc[d * 4 + 3] = fmaf(wk[kk], hi[1], acc[d * 4 + 3]);
      }
    }
  }
  float y[16];
  {
    const u32x4 ha = *reinterpret_cast<const u32x4*>(x + lane * 16), hb2 = *reinterpret_cast<const u32x4*>(x + lane * 16 + 8);
#pragma unroll
    for (int j = 0; j < 4; ++j) {
      y[2 * j] = ALPHA * bflo(ha[j]) + acc[2 * j]; y[2 * j + 1] = ALPHA * bfhi(ha[j]) + acc[2 * j + 1];
      y[8 + 2 * j] = ALPHA * bflo(hb2[j]) + acc[8 + 2 * j]; y[8 + 2 * j + 1] = ALPHA * bfhi(hb2[j]) + acc[8 + 2 * j + 1];
    }
  }
  float s = 0;
#pragma unroll
  for (int j = 0; j < 16; ++j) s += y[j];
  const float mu = wave_sum(s) * (1.f / DM);
  float ss = 0;
#pragma unroll
  for (int j = 0; j < 16; ++j) { const float d = y[j] - mu; ss += d * d; }
  const float rstd = rsqrtf(wave_sum(ss) * (1.f / DM) + LN_EPS);
  float* outp = p.out + (size_t)t * DM + lane * 16;
  const float* g = p.in[I_LNFG] + lane * 16; const float* bb = p.in[I_LNFB] + lane * 16;
#pragma unroll
  for (int c4 = 0; c4 < 4; ++c4) {
    f32x4 o;
#pragma unroll
    for (int j = 0; j < 4; ++j) o[j] = (y[c4 * 4 + j] - mu) * rstd * g[c4 * 4 + j] + bb[c4 * 4 + j];
    *reinterpret_cast<f32x4*>(outp + c4 * 4) = o;
  }
}

#define XB_TMO      128
#define XB_XCNT(j)  (256  + 64 * (j))
#define XB_XSUB(j)  (1280 + 64 * (j))
#define XB_XGEN(j)  (2304 + 64 * (j))
#define XB_TOP      3328
#define XB_TOPGEN   3392
#define XCD_BAR_WORDS 3456
#define XB_SPIN_CAP (1u << 18)
#define LAS __attribute__((address_space(3)))

__device__ __forceinline__ unsigned xb_ld(unsigned* p)              { return __hip_atomic_load(p, __ATOMIC_RELAXED, __HIP_MEMORY_SCOPE_AGENT); }
__device__ __forceinline__ unsigned xb_add(unsigned* p, unsigned v) { return __hip_atomic_fetch_add(p, v, __ATOMIC_RELAXED, __HIP_MEMORY_SCOPE_AGENT); }
#define XB_SPIN(cond, bar) do { unsigned _sp = 0; while (cond) { __builtin_amdgcn_s_sleep(1); \
    if ((++_sp & 255u) == 0u) { if (xb_ld(&(bar)[XB_TMO])) break; if (_sp > XB_SPIN_CAP) { atomicAdd(&(bar)[XB_TMO], 1u); break; } } } } while (0)

struct XcdBarrier {
    unsigned* bar; unsigned x;
    volatile unsigned* st;
};

__device__ __forceinline__ XcdBarrier xcd_barrier_post(unsigned* bar, volatile unsigned* st) {
    XcdBarrier b; b.bar = bar; b.x = xcc_id(); b.st = st;
    if (threadIdx.x == 0) (void)xb_add(&bar[XB_XCNT(b.x)], 1u);
    return b;
}
__device__ __forceinline__ void xcd_barrier_complete(unsigned* bar, unsigned x, unsigned& nloc, unsigned& nx) {
    const unsigned G = gridDim.x * gridDim.y * gridDim.z;
    unsigned sum, cnt, mine, sp = 0u;
    for (;;) {
        sum = 0u; cnt = 0u; mine = 0u;
#pragma unroll
        for (unsigned j = 0; j < 16; ++j) { const unsigned c = xb_ld(&bar[XB_XCNT(j)]); sum += c; cnt += (c > 0u) ? 1u : 0u; mine = (j == x) ? c : mine; }
        if (sum == G) break;
        __builtin_amdgcn_s_sleep(1);
        if ((++sp & 255u) == 0u) { if (xb_ld(&bar[XB_TMO])) break; if (sp > XB_SPIN_CAP) { atomicAdd(&bar[XB_TMO], 1u); break; } }
    }
    nloc = mine > 0u ? mine : 1u; nx = cnt > 0u ? cnt : 1u;
}

__device__ __forceinline__ void xcd_barrier(const XcdBarrier& b) {
    asm volatile("s_waitcnt vmcnt(0)" ::: "memory");
    __syncthreads();
    if (threadIdx.x == 0) {
        unsigned* bar = b.bar;
        __builtin_amdgcn_s_waitcnt(0);
        unsigned nloc = b.st[0], nx = b.st[1];
        if (nloc == 0u) { xcd_barrier_complete(bar, b.x, nloc, nx); b.st[0] = nloc; b.st[1] = nx; }
        const unsigned old = xb_add(&bar[XB_XSUB(b.x)], 1u);
        const unsigned gen = old / nloc;
        if (old + 1u == (gen + 1u) * nloc) {
            __builtin_amdgcn_fence(__ATOMIC_RELEASE, "agent");
            asm volatile("s_waitcnt vmcnt(0)" ::: "memory");
            const unsigned og = xb_add(&bar[XB_TOP], 1u);
            const unsigned tg = og / nx;
            if (og + 1u == (tg + 1u) * nx) xb_add(&bar[XB_TOPGEN], 1u);
            else XB_SPIN(xb_ld(&bar[XB_TOPGEN]) == tg, bar);
            __builtin_amdgcn_fence(__ATOMIC_ACQUIRE, "agent");
            xb_add(&bar[XB_XGEN(b.x)], 1u);
            asm volatile("s_waitcnt vmcnt(0)" ::: "memory");
        } else {
            XB_SPIN(xb_ld(&bar[XB_XGEN(b.x)]) == gen, bar);
            __builtin_amdgcn_fence(__ATOMIC_ACQUIRE, "agent");
            asm volatile("s_waitcnt vmcnt(0)" ::: "memory");
        }
    }
    __syncthreads();
}


constexpr int NPHASES = 11;
template <int ph> DEV void run_phase(const Params& p, char* smem, bool leader) {
  const int bid = blockIdx.x, nb = gridDim.x, tid = threadIdx.x, w = tid >> 6;
  const int gtid = bid * NTHREADS + tid, gsize = nb * NTHREADS;
  {
    if constexpr (ph == 0) {
      for (int it = bid; it < NT / 16; it += nb) ln_x_rows<4>(p, (it * 4 + w) * 4);
      transpose_cvt(p.in[I_WIN], (u16*)(p.ws + WS_WIN), 1024, INW, gtid, gsize);
      transpose_cvt(p.in[I_WUQ], (u16*)(p.ws + WS_WUQ), 256, 768, gtid, gsize);
      transpose_cvt(p.in[I_WUKV], (u16*)(p.ws + WS_WUKV), 128, 1024, gtid, gsize);
      transpose_cvt(p.in[I_WO], (u16*)(p.ws + WS_WO), 1024, 1024, gtid, gsize);
      transpose_cvt(p.in[I_PWQ], (u16*)(p.ws + WS_WQ), 1024, 1024, gtid, gsize);
      cvt_bf16(p.in[I_PSK], (u16*)(p.ws + WS_SUBK), 8 * 2 * 128 * 64 / 8, gtid, gsize);
      cvt_fp8(p.in[I_PU], (unsigned char*)(p.ws + WS_UB), (size_t)16384 * 1024 / 16, 128.f, gtid, gsize);
      cvt_fp8(p.in[I_PV], (unsigned char*)(p.ws + WS_VB), (size_t)16384 * 1024 / 16, 16.f, gtid, gsize);
      rope_table(p, gtid, gsize);
      for (int it = bid; it < 4096 / 4; it += nb) hy_hidden(p, it * 4 + w);
    }
    if constexpr (ph == 1) {
      for (int it = bid; it < 1024; it += nb) filter_build(p, it, smem);
      EpiBf16 epi{(u16*)(p.ws + WS_RA), PLD, INW};
      if (nb == 512) {
        const int xcd = bid & 7, local = bid >> 3, g = local >> 4, ntile = local & 15;
        for (int j = 0; j < 16; ++j)
          gemm_tile((const u16*)(p.ws + WS_HB), DM, (const u16*)(p.ws + WS_WIN), DM, INW, DM, ((xcd * 4 + g) + 32 * j) * 128, ntile * 128, epi, smem);
      } else
      for (int it = bid; it < 512 * 16; it += nb)
        gemm_tile((const u16*)(p.ws + WS_HB), DM, (const u16*)(p.ws + WS_WIN), DM, INW, DM, (it >> 4) * 128, (it & 15) * 128, epi, smem);
    }
    if constexpr (ph == 2) {
      int* q = (int*)(p.ws + WS_CTRL) + 3 * 4096;
      for (int it = next_item(q + 0, smem); it < 1024; it = next_item(q + 0, smem)) kspec_item(p, it, smem);
      for (int it = bid; it < NT / 4; it += nb) token_norms(p, it * 4 + w);
      for (int it = bid; it < NB * 64 * 24; it += nb) shortconv_tile(p, it, smem);
    }
    if constexpr (ph == 3) {
      int* q = (int*)(p.ws + WS_CTRL) + 3 * 4096;
      for (int it = next_item(q + 1, smem); it < 4096; it = next_item(q + 1, smem)) hyena_conv_item(p, it, smem);
      EpiBf16 epiq{(u16*)(p.ws + WS_QRAW), 768, 768};
      EpiKV epikv{(u16*)(p.ws + WS_KN), (u16*)(p.ws + WS_VT)};
      for (int it = next_item(q + 2, smem); it < 512 * 14; it = next_item(q + 2, smem)) {
        if (it < 512 * 6)
          gemm_tile((const u16*)(p.ws + WS_CQN), 256, (const u16*)(p.ws + WS_WUQ), 256, 768, 256, (it / 6) * 128, (it % 6) * 128, epiq, smem);
        else {
          const int i2 = it - 512 * 6;
          gemm_tile((const u16*)(p.ws + WS_CKVN), 128, (const u16*)(p.ws + WS_WUKV), 128, 1024, 128, (i2 >> 3) * 128, (i2 & 7) * 128, epikv, smem);
        }
      }
    }
    if constexpr (ph == 4) {
      if (nb == 512) {
        const int xcd = bid & 7, local = bid >> 3, ps = local >> 5, qb = local & 31;
        for (int j = 0; j < 8; ++j) attention_item(p, ((xcd * 2 + ps) + 16 * j) * 32 + qb, smem);
      } else
      for (int it = bid; it < 4096; it += nb) attention_item(p, it, smem);
      for (int it = bid; it < NB * 64 * 8; it += nb) hyout_tile(p, it, smem);
    }
    if constexpr (ph == 5) {
      EpiBf16 epi{(u16*)(p.ws + WS_MIX), DM, DM};
      if (nb == 512) {
        const int xcd = bid & 7, local = bid >> 3, g = local >> 3, ntile = local & 7;
        for (int j = 0; j < 8; ++j)
          gemm_tile((const u16*)(p.ws + WS_CAT), DM, (const u16*)(p.ws + WS_WO), DM, DM, DM, ((xcd * 8 + g) + 64 * j) * 128, ntile * 128, epi, smem);
      } else
      for (int it = bid; it < 512 * 8; it += nb)
        gemm_tile((const u16*)(p.ws + WS_CAT), DM, (const u16*)(p.ws + WS_WO), DM, DM, DM, (it >> 3) * 128, (it & 7) * 128, epi, smem);
    }
    if constexpr (ph == 6) {
      for (int it = bid; it < NT / 16; it += nb) ln_mix_rows<4>(p, (it * 4 + w) * 4);
    }
    if constexpr (ph == 7) {
      EpiBf16 epi{(u16*)(p.ws + WS_PQ), DM, DM};
      if (nb == 512) {
        const int xcd = bid & 7, local = bid >> 3, g = local >> 3, ntile = local & 7;
        for (int j = 0; j < 8; ++j)
          gemm_tile((const u16*)(p.ws + WS_H2B), DM, (const u16*)(p.ws + WS_WQ), DM, DM, DM, ((xcd * 8 + g) + 64 * j) * 128, ntile * 128, epi, smem);
      } else
      for (int it = bid; it < 512 * 8; it += nb)
        gemm_tile((const u16*)(p.ws + WS_H2B), DM, (const u16*)(p.ws + WS_WQ), DM, DM, DM, (it >> 3) * 128, (it & 7) * 128, epi, smem);
    }
    if constexpr (ph == 8) {
      for (int it = bid; it < NT / 32; it += nb)
        for (int hg = 0; hg < 2; ++hg) routing_group(p, it * 2 + hg, smem);
    }
    if constexpr (ph == 9) {
      for (int it = bid; it < NT / 4; it += nb) peer_u(p, it * 4 + w);
    }
    if constexpr (ph == 10) {
      for (int it = bid; it < NT / 4; it += nb) peer_v(p, it * 4 + w);
    }
  }
}

#if !MULTI_LAUNCH
__global__ void __launch_bounds__(NTHREADS, 2) __attribute__((target("no-packed-fp32-ops"))) mega_kernel(Params p) {
  extern __shared__ __attribute__((aligned(16))) char smem[];
  cg::grid_group grid = cg::this_grid();
  if (threadIdx.x == 0) { ((unsigned*)(smem + LDS_CTRL_OFF))[4] = 0u; ((unsigned*)(smem + LDS_CTRL_OFF))[5] = 0u; }
  __syncthreads();
  const XcdBarrier xb = xcd_barrier_post((unsigned*)(p.ws + WS_CTRL + CTRL_BAR_OFF), (volatile unsigned*)(smem + LDS_CTRL_OFF) + 4);
  int* shw = (int*)(smem + LDS_CTRL_OFF);
  if (threadIdx.x == 0) {
    int* slot = (int*)(p.ws + WS_CTRL);
    const int key = (int)(xcc_id() * 256 + cu_key());
    shw[2] = key;
    shw[0] = (atomicAdd(slot + key, 1) == 0) ? 1 : 0;
  }
  __syncthreads();
  const bool leader = shw[0] != 0;
  run_phase<0>(p, smem, leader);
  if (p.ws == nullptr) grid.sync();
  xcd_barrier(xb);
  run_phase<1>(p, smem, leader); xcd_barrier(xb);
  run_phase<2>(p, smem, leader); xcd_barrier(xb);
  run_phase<3>(p, smem, leader); xcd_barrier(xb);
  run_phase<4>(p, smem, leader); xcd_barrier(xb);
  run_phase<5>(p, smem, leader); xcd_barrier(xb);
  run_phase<6>(p, smem, leader); xcd_barrier(xb);
  run_phase<7>(p, smem, leader); xcd_barrier(xb);
  run_phase<8>(p, smem, leader); xcd_barrier(xb);
  run_phase<9>(p, smem, leader); xcd_barrier(xb);
  run_phase<10>(p, smem, leader);
}
#endif
#ifndef DBG_PHASE
#define DBG_PHASE -1
#endif
__global__ void __launch_bounds__(NTHREADS) hash_kernel(Params p, size_t off, size_t n16, unsigned* word) {
  const u16* src = (const u16*)(p.ws + off);
  unsigned acc = 0;
  for (size_t j = (size_t)blockIdx.x * NTHREADS + threadIdx.x; j < n16; j += (size_t)gridDim.x * NTHREADS) {
    unsigned x = (unsigned)src[j] + 0x9e3779b9u * (unsigned)(j + 1);
    x ^= x >> 16; x *= 0x85ebca6bu; x ^= x >> 13; x *= 0xc2b2ae35u; x ^= x >> 16;
    acc += x;
  }
#pragma unroll
  for (int o = 32; o >= 1; o >>= 1) acc += __shfl_xor(acc, o);
  if ((threadIdx.x & 63) == 0) atomicAdd(word, acc);
}
__global__ void __launch_bounds__(NTHREADS) dump_kernel(Params p, const unsigned* word) {
  const size_t NOUT = (size_t)NT * DM;
  const unsigned w = *word;
  for (size_t i = (size_t)blockIdx.x * NTHREADS + threadIdx.x; i < NOUT; i += (size_t)gridDim.x * NTHREADS) {
    unsigned x = w + (unsigned)i * 0x9e3779b9u; x ^= x >> 16; x *= 0x85ebca6bu; x ^= x >> 13;
    p.out[i] = (float)(x & 0xffffu) * (1.f / 65536.f);
  }
}
#if MULTI_LAUNCH
template <int PH> __global__ void __launch_bounds__(NTHREADS, 2) phase_kernel(Params p) {
  extern __shared__ __attribute__((aligned(16))) char smem[];
  if (threadIdx.x == 0) ((int*)(smem + LDS_CTRL_OFF))[2] = 0;
  __syncthreads();
  run_phase<PH>(p, smem, true);
}
template <int PH> static void launch_phase(const Params& p, int grid, hipStream_t stream) {
  (void)hipFuncSetAttribute((const void*)phase_kernel<PH>, hipFuncAttributeMaxDynamicSharedMemorySize, LDS_BYTES);
  hipLaunchKernelGGL(phase_kernel<PH>, dim3(grid), dim3(NTHREADS), LDS_BYTES, stream, p);
}
#endif

extern "C" void kernel_launch(void* const* d_in, const int* in_sizes, int n_in, void* d_out, int out_size, void* d_ws, size_t ws_size, hipStream_t stream) {
  static int grid_blocks = 0;
  if (!grid_blocks) {
    int dev = 0, cus = 0, per_cu = 0;
    (void)hipGetDevice(&dev);
    (void)hipDeviceGetAttribute(&cus, hipDeviceAttributeMultiprocessorCount, dev);
#if !MULTI_LAUNCH
    (void)hipFuncSetAttribute((const void*)mega_kernel, hipFuncAttributeMaxDynamicSharedMemorySize, LDS_BYTES);
#endif
#if MULTI_LAUNCH
#endif
#if !MULTI_LAUNCH
    (void)hipOccupancyMaxActiveBlocksPerMultiprocessor(&per_cu, (const void*)mega_kernel, NTHREADS, LDS_BYTES);
#else
    per_cu = 2;
#endif
    if (per_cu > 2) per_cu = 2;
    if (per_cu < 1) per_cu = 1;
    grid_blocks = cus * per_cu;
    if (ws_size < WS_END) fprintf(stderr, "kernel_launch: workspace too small: %zu < %zu\n", ws_size, (size_t)WS_END);
  }
  Params p{};
  for (int i = 0; i < 29; ++i) p.in[i] = (const float*)d_in[i];
  p.out = (float*)d_out;
  p.ws = (char*)d_ws;
  (void)hipMemsetAsync((char*)d_ws + WS_CTRL, 0, CTRL_BYTES, stream);
#if MULTI_LAUNCH
  launch_phase<0>(p, grid_blocks, stream);
  if (DBG_PHASE < 0 || DBG_PHASE >= 1) launch_phase<1>(p, grid_blocks, stream);
  if (DBG_PHASE < 0 || DBG_PHASE >= 2) launch_phase<2>(p, grid_blocks, stream);
  if (DBG_PHASE < 0 || DBG_PHASE >= 3) launch_phase<3>(p, grid_blocks, stream);
  if (DBG_PHASE < 0 || DBG_PHASE >= 4) launch_phase<4>(p, grid_blocks, stream);
  if (DBG_PHASE < 0 || DBG_PHASE >= 5) launch_phase<5>(p, grid_blocks, stream);
  if (DBG_PHASE < 0 || DBG_PHASE >= 6) launch_phase<6>(p, grid_blocks, stream);
  if (DBG_PHASE < 0 || DBG_PHASE >= 7) launch_phase<7>(p, grid_blocks, stream);
  if (DBG_PHASE < 0 || DBG_PHASE >= 8) launch_phase<8>(p, grid_blocks, stream);
  if (DBG_PHASE < 0) launch_phase<9>(p, grid_blocks, stream);
  if (DBG_PHASE >= 0) {
    unsigned* word = (unsigned*)((char*)d_ws + WS_END + 65536);
    (void)hipMemsetAsync(word, 0, 4, stream);
    hipLaunchKernelGGL(hash_kernel, dim3(2048), dim3(NTHREADS), 0, stream, p, (size_t)DBG_OFF, (size_t)DBG_N16, word);
    hipLaunchKernelGGL(dump_kernel, dim3(2048), dim3(NTHREADS), 0, stream, p, (const unsigned*)word);
  }
#else
  void* args[] = {&p};
  hipError_t e = hipLaunchCooperativeKernel((const void*)mega_kernel, dim3(grid_blocks), dim3(NTHREADS), args, LDS_BYTES, stream);
  if (e != hipSuccess) fprintf(stderr, "cooperative launch failed: %s (grid %d)\n", hipGetErrorString(e), grid_blocks);
#endif
}
```

```cpp
#include <hip/hip_runtime.h>
#include <hip/hip_bf16.h>
#include <hip/hip_cooperative_groups.h>
#include <cstdio>
#include <cstdint>
namespace cg = cooperative_groups;

#ifndef MULTI_LAUNCH
#define MULTI_LAUNCH 0
#define DBG_PHASE -1
#define DBG_OFF WS_YT
#define DBG_N16 ((size_t)16 * 512 * 4096)
#endif

typedef unsigned short u16;
using bf16x8 = __attribute__((ext_vector_type(8))) short;
using bf16x2 = __attribute__((ext_vector_type(2))) __bf16;
using f32x16 = __attribute__((ext_vector_type(16))) float;
using f32x4 = __attribute__((ext_vector_type(4))) float;
using u32x4 = __attribute__((ext_vector_type(4))) unsigned;
using u32x2 = __attribute__((ext_vector_type(2))) unsigned;
using f32x2 = __attribute__((ext_vector_type(2))) float;

#define HD __host__ __device__ __forceinline__
#define DEV __device__ __forceinline__

constexpr int DM = 1024, NB = 16, SEQ = 4096, NT = NB * SEQ;
constexpr int INW = 1952, PLD = 2048, OFF_CQ = 256, OFF_CKV = 384, OFF_KR = 416;
constexpr int HYW = 512;
constexpr float ALPHA = 1.189207115002721f;
constexpr float LN_EPS = 1e-5f, RMS_EPS = 1e-6f;
constexpr int NTHREADS = 256;
constexpr int LDS_CTRL_OFF = 67584;
constexpr int LDS_BYTES = LDS_CTRL_OFF + 256;

constexpr size_t MiB = 1ull << 20;
constexpr size_t WS_HB = 0;
constexpr size_t WS_RA = 128 * MiB;
constexpr size_t WS_QRAW = WS_RA;
constexpr size_t WS_KN = WS_RA + 96 * MiB;
constexpr size_t WS_VT = WS_RA + 160 * MiB;
constexpr size_t WS_MIX = WS_RA;
constexpr size_t WS_PQ = WS_RA + 128 * MiB;
constexpr size_t WS_CQN = 384 * MiB;
constexpr size_t WS_CKVN = 416 * MiB;
constexpr size_t WS_KPE = 432 * MiB;
constexpr size_t WS_HYT = 440 * MiB;
constexpr size_t WS_CAT = WS_HYT;
constexpr size_t WS_H2B = WS_HYT;
constexpr size_t WS_EIDX = WS_HYT + 128 * MiB;
constexpr size_t WS_GATE = WS_HYT + 160 * MiB;
constexpr size_t WS_YT = 632 * MiB;
constexpr size_t WS_KSPEC = 696 * MiB;
constexpr size_t WS_KC = 760 * MiB;
constexpr size_t WS_UB = 792 * MiB;
constexpr size_t WS_VB = 824 * MiB;
constexpr size_t WS_WIN = 856 * MiB;
constexpr size_t WS_WUQ = 860 * MiB;
constexpr size_t WS_WUKV = 861 * MiB;
constexpr size_t WS_WO = 862 * MiB;
constexpr size_t WS_WQ = 864 * MiB;
constexpr size_t WS_SUBK = 866 * MiB;
constexpr size_t WS_HID2 = 867 * MiB;
constexpr size_t WS_ROPE = 868 * MiB;
constexpr size_t WS_END = 870 * MiB;
constexpr size_t WS_CTRL = WS_END;
constexpr size_t CTRL_BAR_OFF = 65536;
constexpr size_t CTRL_BYTES = CTRL_BAR_OFF + 3456 * 4;

struct Params {
  const float* in[29];
  float* out;
  char* ws;
};
enum { I_X = 0, I_EMB_G, I_EMB_B, I_WIN, I_QNG, I_WUQ, I_KVNG, I_WUKV, I_SHW, I_SHB, I_FW1, I_FB1, I_FFR1, I_FW2, I_FB2, I_FFR2, I_FW3, I_HYB,
       I_AOG, I_HOG, I_WO, I_LNMG, I_LNMB, I_PWQ, I_PSK, I_PU, I_PV, I_LNFG, I_LNFB };

DEV u16 f2bf(float f) { unsigned u = __float_as_uint(f); u += 0x7fffu + ((u >> 16) & 1u); return (u16)(u >> 16); }
DEV float bf2f(u16 h) { return __uint_as_float(((unsigned)h) << 16); }
DEV unsigned pack2(float lo, float hi) { return (unsigned)f2bf(lo) | ((unsigned)f2bf(hi) << 16); }
DEV float bflo(unsigned w) { return __uint_as_float(w << 16); }
DEV float bfhi(unsigned w) { return __uint_as_float(w & 0xffff0000u); }
DEV float wave_sum(float v) {
#pragma unroll
  for (int o = 32; o >= 1; o >>= 1) v += __shfl_xor(v, o);
  return v;
}
DEV float dot2bf(unsigned a, unsigned b, float acc) {
  return __builtin_amdgcn_fdot2_f32_bf16(__builtin_bit_cast(bf16x2, a), __builtin_bit_cast(bf16x2, b), acc, false);
}
DEV int crow(int r, int hi) { return (r & 3) + 8 * (r >> 2) + 4 * hi; }
#define LGKM0() asm volatile("s_waitcnt lgkmcnt(0)" ::: "memory")

DEV unsigned xcc_id() { return (unsigned)__builtin_amdgcn_s_getreg(20 | (3 << 11)) & 0xfu; }
DEV unsigned cu_key() { return ((unsigned)__builtin_amdgcn_s_getreg(63492) >> 8) & 0xffu; }
DEV int next_item(int* q, char* smem) {
  int* shw = (int*)(smem + LDS_CTRL_OFF);
  __syncthreads();
  if (threadIdx.x == 0) shw[1] = atomicAdd(q, 1);
  __syncthreads();
  return shw[1];
}
DEV void fft_seam(int* flags, char* smem, bool leader) {
  int* shw = (int*)(smem + LDS_CTRL_OFF);
  __syncthreads();
  if (threadIdx.x == 0) {
    const int key = shw[2];
    if (leader) { __threadfence(); atomicExch(flags + key, 1); }
    else { while (atomicAdd(flags + key, 0) == 0) __builtin_amdgcn_s_sleep(64); }
  }
  __syncthreads();
}
static constexpr float kCos32[32] = {1.000000000e+00f, 9.807852804e-01f, 9.238795325e-01f, 8.314696123e-01f, 7.071067812e-01f, 5.555702330e-01f, 3.826834324e-01f, 1.950903220e-01f, 0.0f, -1.950903220e-01f, -3.826834324e-01f, -5.555702330e-01f, -7.071067812e-01f, -8.314696123e-01f, -9.238795325e-01f, -9.807852804e-01f, -1.000000000e+00f, -9.807852804e-01f, -9.238795325e-01f, -8.314696123e-01f, -7.071067812e-01f, -5.555702330e-01f, -3.826834324e-01f, -1.950903220e-01f, 0.0f, 1.950903220e-01f, 3.826834324e-01f, 5.555702330e-01f, 7.071067812e-01f, 8.314696123e-01f, 9.238795325e-01f, 9.807852804e-01f};
static constexpr float kSin32[32] = {0.000000000e+00f, 1.950903220e-01f, 3.826834324e-01f, 5.555702330e-01f, 7.071067812e-01f, 8.314696123e-01f, 9.238795325e-01f, 9.807852804e-01f, 1.000000000e+00f, 9.807852804e-01f, 9.238795325e-01f, 8.314696123e-01f, 7.071067812e-01f, 5.555702330e-01f, 3.826834324e-01f, 1.950903220e-01f, 0.0f, -1.950903220e-01f, -3.826834324e-01f, -5.555702330e-01f, -7.071067812e-01f, -8.314696123e-01f, -9.238795325e-01f, -9.807852804e-01f, -1.000000000e+00f, -9.807852804e-01f, -9.238795325e-01f, -8.314696123e-01f, -7.071067812e-01f, -5.555702330e-01f, -3.826834324e-01f, -1.950903220e-01f};

struct cf2 { float x, y; };
HD int PADI(int i) { return i + (i >> 5); }
DEV int PADL(int i) { return PADI(i); }
constexpr int FFT_N = 8192;

template <int R> struct Log2 { static constexpr int v = 1 + Log2<R / 2>::v; };
template <> struct Log2<1> { static constexpr int v = 0; };
template <int R> HD constexpr int bitrev_c(int r) {
  int o = 0;
  for (int b = 0; b < Log2<R>::v; ++b) o |= ((r >> b) & 1) << (Log2<R>::v - 1 - b);
  return o;
}
template <int R> DEV void dft_regs(float (&re)[R], float (&im)[R]) {
#pragma unroll
  for (int ls = Log2<R>::v - 1; ls >= 0; --ls) {
    const int s = 1 << ls;
#pragma unroll
    for (int i = 0; i < R; ++i) {
      if ((i & s) == 0) {
        const int j = i + s;
        const int tw = (i & (s - 1)) * (R / (2 * s)) * (32 / R);
        const float ar = re[i], ai = im[i], br = re[j], bi = im[j];
        re[i] = ar + br; im[i] = ai + bi;
        const float dr = ar - br, di = ai - bi;
        const float c = kCos32[tw], sn = kSin32[tw];
        re[j] = dr * c + di * sn;
        im[j] = di * c - dr * sn;
      }
    }
  }
}
DEV void twiddle1(int lo, int Ncur, float& c, float& s) {
  const float a = 2.0f * (float)lo / (float)Ncur;
  c = cospif(a); s = -sinpif(a);
}
template <int R> DEV void fft_pass_fwd(cf2* X, int unit, int q, int Ncur) {
  const int lo = unit & (q - 1), seg = unit / q, base = seg * Ncur + lo;
  float re[R], im[R];
#pragma unroll
  for (int j = 0; j < R; ++j) { cf2 v = X[PADL(base + j * q)]; re[j] = v.x; im[j] = v.y; }
  dft_regs<R>(re, im);
  if (q > 1) {
    float c1, s1; twiddle1(lo, Ncur, c1, s1);
    float wr = 1.f, wi = 0.f;
#pragma unroll
    for (int r = 1; r < R; ++r) {
      const float nwr = wr * c1 - wi * s1, nwi = wr * s1 + wi * c1; wr = nwr; wi = nwi;
      const int k = bitrev_c<R>(r);
      const float xr = re[k], xi = im[k];
      re[k] = xr * wr - xi * wi; im[k] = xr * wi + xi * wr;
    }
  }
#pragma unroll
  for (int r = 0; r < R; ++r) { cf2 v; v.x = re[bitrev_c<R>(r)]; v.y = im[bitrev_c<R>(r)]; X[PADL(base + r * q)] = v; }
}
template <int R> DEV void fft_pass_inv(cf2* X, int unit, int q, int Ncur) {
  const int lo = unit & (q - 1), seg = unit / q, base = seg * Ncur + lo;
  float re[R], im[R];
#pragma unroll
  for (int r = 0; r < R; ++r) { cf2 v = X[PADL(base + r * q)]; re[r] = v.x; im[r] = v.y; }
  if (q > 1) {
    float c1, s1; twiddle1(lo, Ncur, c1, s1); s1 = -s1;
    float wr = 1.f, wi = 0.f;
#pragma unroll
    for (int r = 1; r < R; ++r) {
      const float nwr = wr * c1 - wi * s1, nwi = wr * s1 + wi * c1; wr = nwr; wi = nwi;
      const float xr = re[r], xi = im[r];
      re[r] = xr * wr - xi * wi; im[r] = xr * wi + xi * wr;
    }
  }
#pragma unroll
  for (int r = 0; r < R; ++r) im[r] = -im[r];
  dft_regs<R>(re, im);
#pragma unroll
  for (int j = 0; j < R; ++j) { cf2 v; v.x = re[bitrev_c<R>(j)]; v.y = -im[bitrev_c<R>(j)]; X[PADL(base + j * q)] = v; }
}
DEV void fft_fwd_block(cf2* X) {
  int tid = threadIdx.x;
  asm volatile("" : "+v"(tid));
#pragma unroll 1
  for (int u = tid; u < 512; u += 256) fft_pass_fwd<16>(X, u, 512, 8192);
  __syncthreads();
#pragma unroll 1
  for (int u = tid; u < 512; u += 256) fft_pass_fwd<16>(X, u, 32, 512);
  __syncthreads();
  fft_pass_fwd<32>(X, tid, 1, 32);
  __syncthreads();
}
DEV void fft_inv_block(cf2* X) {
  int tid = threadIdx.x;
  asm volatile("" : "+v"(tid));
  fft_pass_inv<32>(X, tid, 1, 32);
  __syncthreads();
#pragma unroll 1
  for (int u = tid; u < 512; u += 256) fft_pass_inv<16>(X, u, 32, 512);
  __syncthreads();
#pragma unroll 1
  for (int u = tid; u < 512; u += 256) fft_pass_inv<16>(X, u, 512, 8192);
  __syncthreads();
}

DEV void fft_mid_fused(cf2* X, int tid, const cf2* __restrict__ ks) {
  const int base = tid * 32;
  float re[32], im[32];
#pragma unroll
  for (int j = 0; j < 32; ++j) { cf2 v = X[PADL(base + j)]; re[j] = v.x; im[j] = v.y; }
  f32x4 kk[16];
#pragma unroll
  for (int r = 0; r < 16; ++r) kk[r] = *reinterpret_cast<const f32x4*>(ks + base + 2 * r);
  dft_regs<32>(re, im);
  float re2[32], im2[32];
#pragma unroll
  for (int r = 0; r < 32; ++r) {
    const int idx = bitrev_c<32>(r);
    const float kx = kk[r >> 1][(r & 1) * 2], ky = kk[r >> 1][(r & 1) * 2 + 1];
    const float xr = re[idx], xi = im[idx];
    re2[r] = xr * kx - xi * ky; im2[r] = -(xr * ky + xi * kx);
  }
  dft_regs<32>(re2, im2);
#pragma unroll
  for (int j = 0; j < 32; ++j) { cf2 v; v.x = re2[bitrev_c<32>(j)]; v.y = -im2[bitrev_c<32>(j)]; X[PADL(base + j)] = v; }
}
DEV void fft_conv_block(cf2* X, const cf2* __restrict__ ks) {
  int tid = threadIdx.x;
  asm volatile("" : "+v"(tid));
#pragma unroll 1
  for (int u = tid; u < 512; u += 256) fft_pass_fwd<16>(X, u, 512, 8192);
  __syncthreads();
#pragma unroll 1
  for (int u = tid; u < 512; u += 256) fft_pass_fwd<16>(X, u, 32, 512);
  __syncthreads();
  fft_mid_fused(X, tid, ks);
  __syncthreads();
#pragma unroll 1
  for (int u = tid; u < 512; u += 256) fft_pass_inv<16>(X, u, 32, 512);
  __syncthreads();
#pragma unroll 1
  for (int u = tid; u < 512; u += 256) fft_pass_inv<16>(X, u, 512, 8192);
  __syncthreads();
}

constexpr int GLD = 72;
DEV void store_wave_tile(const f32x16& a00, const f32x16& a01, const f32x16& a10, const f32x16& a11, u16* Cw, u16* dst, int ldc, int ncols_valid) {
  const int lane = threadIdx.x & 63, r32 = lane & 31, hi = lane >> 5;
#pragma unroll
  for (int r = 0; r < 16; ++r) {
    const int row = crow(r, hi);
    Cw[row * GLD + r32] = f2bf(a00[r]);
    Cw[row * GLD + 32 + r32] = f2bf(a01[r]);
    Cw[(32 + row) * GLD + r32] = f2bf(a10[r]);
    Cw[(32 + row) * GLD + 32 + r32] = f2bf(a11[r]);
  }
  LGKM0();
#pragma unroll
  for (int t = 0; t < 8; ++t) {
    const int id = lane + 64 * t, row = id >> 3, cc = id & 7;
    const u32x4 v = *reinterpret_cast<const u32x4*>(Cw + row * GLD + cc * 8);
    if (cc * 8 < ncols_valid) *reinterpret_cast<u32x4*>(dst + (size_t)row * ldc + cc * 8) = v;
  }
  LGKM0();
}
struct EpiBf16 {
  u16* C; int ldc; int N;
  DEV void store(const f32x16& a00, const f32x16& a01, const f32x16& a10, const f32x16& a11, int m0, int n0, int wm, int wn, u16* Cw) const {
    const int c0 = n0 + wn * 64;
    store_wave_tile(a00, a01, a10, a11, Cw, C + (size_t)(m0 + wm * 64) * ldc + c0, ldc, N - c0);
  }
  DEV void operator()(int row0, int col, float v0, float v1, float v2, float v3) const {
    if (col < N) {
      u16* p = C + (size_t)row0 * ldc + col;
      p[0] = f2bf(v0); p[ldc] = f2bf(v1); p[2 * ldc] = f2bf(v2); p[3 * ldc] = f2bf(v3);
    }
  }
};
struct EpiKV {
  u16* kn; u16* vt;
  DEV void store(const f32x16& a00, const f32x16& a01, const f32x16& a10, const f32x16& a11, int m0, int n0, int wm, int wn, u16* Cw) const {
    if (wn == 0) {
      store_wave_tile(a00, a01, a10, a11, Cw, kn + (size_t)(m0 + wm * 64) * 512 + (n0 >> 7) * 64, 512, 64);
    } else {
      const int lane = threadIdx.x & 63, r32 = lane & 31, hi = lane >> 5;
      const int rbase = m0 + wm * 64 + 4 * hi, cbase = n0 + 64 + r32;
#pragma unroll
      for (int g = 0; g < 4; ++g) {
        (*this)(rbase + 8 * g, cbase, a00[4 * g], a00[4 * g + 1], a00[4 * g + 2], a00[4 * g + 3]);
        (*this)(rbase + 8 * g, cbase + 32, a01[4 * g], a01[4 * g + 1], a01[4 * g + 2], a01[4 * g + 3]);
        (*this)(rbase + 32 + 8 * g, cbase, a10[4 * g], a10[4 * g + 1], a10[4 * g + 2], a10[4 * g + 3]);
        (*this)(rbase + 32 + 8 * g, cbase + 32, a11[4 * g], a11[4 * g + 1], a11[4 * g + 2], a11[4 * g + 3]);
      }
    }
  }
  DEV void operator()(int row0, int col, float v0, float v1, float v2, float v3) const {
    const int h = col >> 7, j = col & 127;
    if (j < 64) {
      u16* p = kn + (size_t)row0 * 512 + h * 64 + j;
      p[0] = f2bf(v0); p[512] = f2bf(v1); p[1024] = f2bf(v2); p[1536] = f2bf(v3);
    } else {
      const int b = row0 >> 12, s = row0 & 4095;
      u16* p = vt + ((size_t)((b * 8 + h) * 64 + (j - 64))) * 4096 + s;
      u32x2 w = {pack2(v0, v1), pack2(v2, v3)};
      *reinterpret_cast<u32x2*>(p) = w;
    }
  }
};

template <class Epi>
DEV void gemm_tile(const u16* __restrict__ A, int lda, const u16* __restrict__ Bt, int ldb, int N, int K, int m0, int n0, const Epi& epi, char* smem) {
  u16* As = (u16*)smem; u16* Bs = As + 128 * GLD;
  const int tid = threadIdx.x, lane = tid & 63, w = tid >> 6, wm = w >> 1, wn = w & 1, r32 = lane & 31, hi = lane >> 5;
  const int srow = tid >> 3, scc = tid & 7;
  f32x16 acc00 = {}, acc01 = {}, acc10 = {}, acc11 = {};
  u32x4 ra0[4], rb0[4], ra1[4], rb1[4];
  const u16* Ag = A + (size_t)(m0 + srow) * lda + scc * 8;
  const u16* Bg = Bt + (size_t)(n0 + srow) * ldb + scc * 8;
#define GLOAD(RA, RB, KOFF) do { _Pragma("unroll") for (int i = 0; i < 4; ++i) {                                   \
    RA[i] = *reinterpret_cast<const u32x4*>(Ag + (size_t)(32 * i) * lda + (KOFF));                                    \
    RB[i] = (n0 + srow + 32 * i < N) ? *reinterpret_cast<const u32x4*>(Bg + (size_t)(32 * i) * ldb + (KOFF)) : u32x4{0, 0, 0, 0}; } } while (0)
#define SWRITE(RA, RB) do { _Pragma("unroll") for (int i = 0; i < 4; ++i) {                                          \
    *reinterpret_cast<u32x4*>(As + (srow + 32 * i) * GLD + scc * 8) = RA[i];                                          \
    *reinterpret_cast<u32x4*>(Bs + (srow + 32 * i) * GLD + scc * 8) = RB[i]; } } while (0)
#define COMPUTE() do { _Pragma("unroll") for (int kk = 0; kk < 4; ++kk) {                                            \
    const bf16x8 a0 = *reinterpret_cast<const bf16x8*>(As + (wm * 64 + r32) * GLD + kk * 16 + hi * 8);               \
    const bf16x8 a1 = *reinterpret_cast<const bf16x8*>(As + (wm * 64 + 32 + r32) * GLD + kk * 16 + hi * 8);          \
    const bf16x8 b0 = *reinterpret_cast<const bf16x8*>(Bs + (wn * 64 + r32) * GLD + kk * 16 + hi * 8);               \
    const bf16x8 b1 = *reinterpret_cast<const bf16x8*>(Bs + (wn * 64 + 32 + r32) * GLD + kk * 16 + hi * 8);          \
    acc00 = __builtin_amdgcn_mfma_f32_32x32x16_bf16(a0, b0, acc00, 0, 0, 0);                                          \
    acc01 = __builtin_amdgcn_mfma_f32_32x32x16_bf16(a0, b1, acc01, 0, 0, 0);                                          \
    acc10 = __builtin_amdgcn_mfma_f32_32x32x16_bf16(a1, b0, acc10, 0, 0, 0);                                          \
    acc11 = __builtin_amdgcn_mfma_f32_32x32x16_bf16(a1, b1, acc11, 0, 0, 0); } } while (0)
  GLOAD(ra0, rb0, 0);
  GLOAD(ra1, rb1, 64);
  for (int k0 = 0; k0 < K; k0 += 128) {
    __syncthreads();
    SWRITE(ra0, rb0);
    __syncthreads();
    if (k0 + 128 < K) GLOAD(ra0, rb0, k0 + 128);
    COMPUTE();
    __syncthreads();
    SWRITE(ra1, rb1);
    __syncthreads();
    if (k0 + 192 < K) GLOAD(ra1, rb1, k0 + 192);
    COMPUTE();
  }
#undef GLOAD
#undef SWRITE
#undef COMPUTE
  __syncthreads();
  epi.store(acc00, acc01, acc10, acc11, m0, n0, wm, wn, (u16*)smem + w * (64 * GLD));
}

template <int NR>
DEV void ln_x_rows(const Params& p, int row0) {
  const int lane = threadIdx.x & 63;
  f32x4 v[NR][4];
#pragma unroll
  for (int r = 0; r < NR; ++r) {
    const float* x = p.in[I_X] + (size_t)(row0 + r) * DM;
#pragma unroll
    for (int i = 0; i < 4; ++i) v[r][i] = *reinterpret_cast<const f32x4*>(x + i * 256 + lane * 4);
  }
  float mu[NR], rstd[NR];
#pragma unroll
  for (int r = 0; r < NR; ++r) {
    float s = 0;
#pragma unroll
    for (int i = 0; i < 4; ++i) s += v[r][i][0] + v[r][i][1] + v[r][i][2] + v[r][i][3];
    mu[r] = wave_sum(s) * (1.f / DM);
  }
#pragma unroll
  for (int r = 0; r < NR; ++r) {
    float ss = 0;
#pragma unroll
    for (int i = 0; i < 4; ++i) { for (int j = 0; j < 4; ++j) { const float d = v[r][i][j] - mu[r]; ss += d * d; } }
    rstd[r] = rsqrtf(wave_sum(ss) * (1.f / DM) + LN_EPS);
  }
#pragma unroll
  for (int i = 0; i < 4; ++i) {
    const int c = i * 256 + lane * 4;
    const f32x4 g = *reinterpret_cast<const f32x4*>(p.in[I_EMB_G] + c), b = *reinterpret_cast<const f32x4*>(p.in[I_EMB_B] + c);
#pragma unroll
    for (int r = 0; r < NR; ++r) {
      u16* hb = (u16*)(p.ws + WS_HB) + (size_t)(row0 + r) * DM;
      u32x2 o = {pack2((v[r][i][0] - mu[r]) * rstd[r] * g[0] + b[0], (v[r][i][1] - mu[r]) * rstd[r] * g[1] + b[1]),
                 pack2((v[r][i][2] - mu[r]) * rstd[r] * g[2] + b[2], (v[r][i][3] - mu[r]) * rstd[r] * g[3] + b[3])};
      *reinterpret_cast<u32x2*>(hb + c) = o;
    }
  }
}
DEV void transpose_cvt(const float* __restrict__ in, u16* __restrict__ out, int K, int N, int gtid, int gsize) {
  const int total = (K >> 6) * N;
  for (int idx = gtid; idx < total; idx += gsize) {
    const int kg = idx / N, n = idx - kg * N;
    const float* src = in + (size_t)(kg * 64) * N + n;
    u16* dst = out + (size_t)n * K + kg * 64;
#pragma unroll
    for (int c = 0; c < 8; ++c) {
      float v[8];
#pragma unroll
      for (int j = 0; j < 8; ++j) v[j] = src[(size_t)(c * 8 + j) * N];
      *reinterpret_cast<u32x4*>(dst + c * 8) = u32x4{pack2(v[0], v[1]), pack2(v[2], v[3]), pack2(v[4], v[5]), pack2(v[6], v[7])};
    }
  }
}
DEV void cvt_bf16(const float* __restrict__ in, u16* __restrict__ out, size_t n8, size_t gtid, size_t gsize) {
  for (size_t i = gtid; i < n8; i += gsize) {
    const f32x4 a = *reinterpret_cast<const f32x4*>(in + i * 8), b = *reinterpret_cast<const f32x4*>(in + i * 8 + 4);
    u32x4 o = {pack2(a[0], a[1]), pack2(a[2], a[3]), pack2(b[0], b[1]), pack2(b[2], b[3])};
    *reinterpret_cast<u32x4*>(out + i * 8) = o;
  }
}
DEV void cvt_fp8(const float* __restrict__ in, unsigned char* __restrict__ out, size_t n16, float scale, size_t gtid, size_t gsize) {
  for (size_t i = gtid; i < n16; i += gsize) {
    unsigned w[4];
#pragma unroll
    for (int c = 0; c < 4; ++c) {
      const f32x4 a = *reinterpret_cast<const f32x4*>(in + i * 16 + c * 4);
      int t = __builtin_amdgcn_cvt_pk_fp8_f32(a[0] * scale, a[1] * scale, 0, false);
      t = __builtin_amdgcn_cvt_pk_fp8_f32(a[2] * scale, a[3] * scale, t, true);
      w[c] = (unsigned)t;
    }
    *reinterpret_cast<u32x4*>(out + i * 16) = u32x4{w[0], w[1], w[2], w[3]};
  }
}
DEV void hy_hidden(const Params& p, int l) {
  const int lane = threadIdx.x & 63;
  const float t = (float)l / 4095.0f;
  const float wl = 6.283185307179586f * (float)l / 4096.0f;
  const int j = lane & 15;
  const float fj = 1e-4f + (float)j * ((15.0f - 1e-4f) / 15.0f);
  const float ang = wl * fj;
  const float zc = cosf(ang), zs = -sinf(ang);
  const float* w1 = p.in[I_FW1];
  float pre = p.in[I_FB1][lane] + t * w1[lane];
#pragma unroll
  for (int jj = 0; jj < 16; ++jj) {
    pre += __shfl(zc, jj) * w1[(1 + jj) * 64 + lane];
    pre += __shfl(zs, jj) * w1[(17 + jj) * 64 + lane];
  }
  const float h1 = sinf(p.in[I_FFR1][lane] * pre);
  const float* w2 = p.in[I_FW2];
  float pre2 = p.in[I_FB2][lane];
#pragma unroll 8
  for (int k = 0; k < 64; ++k) pre2 += __shfl(h1, k) * w2[k * 64 + lane];
  const float h2 = sinf(p.in[I_FFR2][lane] * pre2);
  ((float*)(p.ws + WS_HID2))[l * 64 + lane] = h2;
}
DEV void rope_table(const Params& p, int gtid, int gsize) {
  float* ct = (float*)(p.ws + WS_ROPE); float* st = ct + 4096 * 16;
  for (int idx = gtid; idx < 4096 * 16; idx += gsize) {
    const int s = idx >> 4, i = idx & 15;
    const float inv = 1.0f / powf(10000.0f, (float)(2 * i) / 32.0f);
    const float ang = (float)s * inv;
    ct[idx] = cosf(ang); st[idx] = sinf(ang);
  }
}

DEV void filter_build(const Params& p, int item, char* smem) {
  const int o = item >> 9, c = item & 511, tid = threadIdx.x;
  const int nf = (o * 2 + 0) * 512 + c, nb = (o * 2 + 1) * 512 + c;
  const float* w3 = p.in[I_FW3];
  const float* hid2 = (const float*)(p.ws + WS_HID2);
  float* red = (float*)smem;
  const float min_decay = -3.0701134573253945f, max_decay = -15.350567286626973f;
  const float delta = fabsf(min_decay + (float)c * ((max_decay - min_decay) / 511.0f));
  float hf[16], hb[16];
#pragma unroll
  for (int i = 0; i < 16; ++i) { hf[i] = 0.f; hb[i] = 0.f; }
#pragma unroll 1
  for (int k4 = 0; k4 < 16; ++k4) {
    float wf[4], wb[4];
#pragma unroll
    for (int j = 0; j < 4; ++j) { wf[j] = w3[(k4 * 4 + j) * 2048 + nf]; wb[j] = w3[(k4 * 4 + j) * 2048 + nb]; }
#pragma unroll
    for (int i = 0; i < 16; ++i) {
      const f32x4 hv = *reinterpret_cast<const f32x4*>(hid2 + (tid + 256 * i) * 64 + k4 * 4);
#pragma unroll
      for (int j = 0; j < 4; ++j) { hf[i] += hv[j] * wf[j]; hb[i] += hv[j] * wb[j]; }
    }
  }
  float sf = 0, sb = 0;
#pragma unroll
  for (int i = 0; i < 16; ++i) {
    const int l = tid + 256 * i;
    const float dec = expf(-((float)l / 4095.0f) * delta);
    hf[i] *= dec; hb[i] *= dec;
    sf += fabsf(hf[i]); sb += fabsf(hb[i]);
  }
  sf = wave_sum(sf); sb = wave_sum(sb);
  __syncthreads();
  if ((tid & 63) == 0) { red[(tid >> 6) * 2] = sf; red[(tid >> 6) * 2 + 1] = sb; }
  __syncthreads();
  const float tf = red[0] + red[2] + red[4] + red[6], tb = red[1] + red[3] + red[5] + red[7];
  const float nf_ = 1.0f / (tf + 1e-6f), nb_ = 1.0f / (tb + 1e-6f);
  float* kc = (float*)(p.ws + WS_KC) + (size_t)item * 8192;
#pragma unroll
  for (int i = 0; i < 16; ++i) {
    const int l = tid + 256 * i;
    const float f = hf[i] * nf_, b = hb[i] * nb_;
    if (l == 0) { kc[0] = f + b; kc[4096] = 0.f; }
    else { kc[l] = f; kc[8192 - l] = b; }
  }
}

DEV void token_norms(const Params& p, int t) {
  const int lane = threadIdx.x & 63;
  const u16* pr = (const u16*)(p.ws + WS_RA) + (size_t)t * PLD;
  {
    const u32x2 w = *reinterpret_cast<const u32x2*>(pr + lane * 4);
    const float v0 = bflo(w[0]), v1 = bfhi(w[0]), v2 = bflo(w[1]), v3 = bfhi(w[1]);
    const float r = rsqrtf(wave_sum(v0 * v0 + v1 * v1 + v2 * v2 + v3 * v3) * (1.f / 256.f) + RMS_EPS);
    const f32x4 g = *reinterpret_cast<const f32x4*>(p.in[I_QNG] + lane * 4);
    u32x2 o = {pack2(v0 * r * g[0], v1 * r * g[1]), pack2(v2 * r * g[2], v3 * r * g[3])};
    *reinterpret_cast<u32x2*>((u16*)(p.ws + WS_CQN) + (size_t)t * 256 + lane * 4) = o;
  }
  {
    const unsigned w = *reinterpret_cast<const unsigned*>(pr + OFF_CQ + lane * 2);
    const float v0 = bflo(w), v1 = bfhi(w);
    const float r = rsqrtf(wave_sum(v0 * v0 + v1 * v1) * (1.f / 128.f) + RMS_EPS);
    const float g0 = p.in[I_KVNG][lane * 2], g1 = p.in[I_KVNG][lane * 2 + 1];
    *reinterpret_cast<unsigned*>((u16*)(p.ws + WS_CKVN) + (size_t)t * 128 + lane * 2) = pack2(v0 * r * g0, v1 * r * g1);
  }
  if (lane < 16) {
    const float x1 = bf2f(pr[OFF_CKV + lane]), x2 = bf2f(pr[OFF_CKV + 16 + lane]);
    const int s = t & 4095;
    const float* ct = (const float*)(p.ws + WS_ROPE);
    const float c = ct[s * 16 + lane], sn = ct[4096 * 16 + s * 16 + lane];
    u16* kp = (u16*)(p.ws + WS_KPE) + (size_t)t * 32;
    kp[lane] = f2bf(x1 * c - x2 * sn); kp[16 + lane] = f2bf(x1 * sn + x2 * c);
  }
}
DEV void shortconv_tile(const Params& p, int item, char* smem) {
  const int cb = item % 24, tb = (item / 24) & 63, b = item / (24 * 64);
  const int tid = threadIdx.x, t0 = tb * 64;
  float* tile = (float*)smem;
  const u16* pr = (const u16*)(p.ws + WS_RA);
  __syncthreads();
  for (int ch = tid; ch < 66 * 8; ch += 256) {
    const int row = ch >> 3, cc = ch & 7, t = t0 - 1 + row;
    u32x4 w = {0, 0, 0, 0};
    if (t >= 0 && t < SEQ) w = *reinterpret_cast<const u32x4*>(pr + (size_t)(b * SEQ + t) * PLD + OFF_KR + cb * 64 + cc * 8);
    float* d = tile + row * 65 + cc * 8;
#pragma unroll
    for (int j = 0; j < 4; ++j) { d[2 * j] = bflo(w[j]); d[2 * j + 1] = bfhi(w[j]); }
  }
  __syncthreads();
  const int c = tid >> 2, tq = (tid & 3) * 16, chn = cb * 64 + c;
  const float* sw = p.in[I_SHW];
  const float w0 = sw[chn], w1 = sw[1536 + chn], w2 = sw[3072 + chn], bias = p.in[I_SHB][chn];
  unsigned o[8];
#pragma unroll
  for (int j = 0; j < 8; ++j) {
    const int ta = tq + 2 * j;
    const float y0 = bias + w0 * tile[ta * 65 + c] + w1 * tile[(ta + 1) * 65 + c] + w2 * tile[(ta + 2) * 65 + c];
    const float y1 = bias + w0 * tile[(ta + 1) * 65 + c] + w1 * tile[(ta + 2) * 65 + c] + w2 * tile[(ta + 3) * 65 + c];
    o[j] = pack2(y0, y1);
  }
  u16* dst = (u16*)(p.ws + WS_HYT) + ((size_t)(b * 1536 + chn)) * SEQ + t0 + tq;
  *reinterpret_cast<u32x4*>(dst) = u32x4{o[0], o[1], o[2], o[3]};
  *reinterpret_cast<u32x4*>(dst + 8) = u32x4{o[4], o[5], o[6], o[7]};
}
DEV void kspec_item(const Params& p, int item, char* smem) {
  cf2* X = (cf2*)smem;
  const int tid = threadIdx.x;
  const float* kc = (const float*)(p.ws + WS_KC) + (size_t)item * 8192;
  __syncthreads();
  for (int i = tid; i < 8192; i += 256) { cf2 v; v.x = kc[i]; v.y = 0.f; X[PADI(i)] = v; }
  __syncthreads();
  fft_fwd_block(X);
  cf2* ks = (cf2*)(p.ws + WS_KSPEC) + (size_t)item * 8192;
  for (int i = tid; i < 8192; i += 256) { cf2 v = X[PADI(i)]; v.x *= (1.f / 8192.f); v.y *= (1.f / 8192.f); ks[i] = v; }
}

template <int O>
DEV void hyena_conv_round(const Params& p, cf2* X, int c, int b0, int b1, float* scr) {
  const int tid = threadIdx.x;
  const u16* hyT = (const u16*)(p.ws + WS_HYT);
  const cf2* ks = (const cf2*)(p.ws + WS_KSPEC) + ((size_t)(O * 512 + c)) * 8192;
  fft_conv_block(X, ks);
  const float bias = p.in[I_HYB][O * 512 + c];
  const u16* g0p = hyT + ((size_t)(b0 * 1536 + (O + 1) * 512 + c)) * SEQ;
  const u16* g1p = hyT + ((size_t)(b1 * 1536 + (O + 1) * 512 + c)) * SEQ;
  const u16* v0p = hyT + ((size_t)(b0 * 1536 + c)) * SEQ;
  const u16* v1p = hyT + ((size_t)(b1 * 1536 + c)) * SEQ;
  u16* yT = (u16*)(p.ws + WS_YT);
  u16* y0p = yT + ((size_t)(b0 * 512 + c)) * SEQ;
  u16* y1p = yT + ((size_t)(b1 * 512 + c)) * SEQ;
#pragma unroll 4
  for (int i = 0; i < 8; ++i) {
    const int t = i * 512 + tid * 2;
    const unsigned ga = *reinterpret_cast<const unsigned*>(g0p + t), gb = *reinterpret_cast<const unsigned*>(g1p + t);
    const cf2 ya = X[PADI(t)], yb = X[PADI(t + 1)];
    f32x4 zp;
    if constexpr (O == 0) {
      const unsigned a = *reinterpret_cast<const unsigned*>(v0p + t), bq = *reinterpret_cast<const unsigned*>(v1p + t);
      zp[0] = bflo(a); zp[1] = bflo(bq); zp[2] = bfhi(a); zp[3] = bfhi(bq);
    } else {
      zp = *reinterpret_cast<const f32x4*>(scr + 2 * t);
    }
    f32x4 zn;
    zn[0] = bflo(ga) * (ya.x + bias * zp[0]);
    zn[1] = bflo(gb) * (ya.y + bias * zp[1]);
    zn[2] = bfhi(ga) * (yb.x + bias * zp[2]);
    zn[3] = bfhi(gb) * (yb.y + bias * zp[3]);
    if constexpr (O == 0) {
      *reinterpret_cast<f32x4*>(scr + 2 * t) = zn;
      cf2 e0; e0.x = zn[0]; e0.y = zn[1]; X[PADI(t)] = e0;
      cf2 e1; e1.x = zn[2]; e1.y = zn[3]; X[PADI(t + 1)] = e1;
      cf2 zz; zz.x = 0.f; zz.y = 0.f; X[PADI(4096 + t)] = zz; X[PADI(4096 + t + 1)] = zz;
    } else {
      *reinterpret_cast<unsigned*>(y0p + t) = pack2(zn[0], zn[2]);
      *reinterpret_cast<unsigned*>(y1p + t) = pack2(zn[1], zn[3]);
    }
  }
  __syncthreads();
}
DEV void hyena_conv_item(const Params& p, int item, char* smem) {
  cf2* X = (cf2*)smem;
  const int tid = threadIdx.x, c = item >> 3, bp = item & 7, b0 = bp * 2, b1 = bp * 2 + 1;
  const u16* hyT = (const u16*)(p.ws + WS_HYT);
  const u16* v0p = hyT + ((size_t)(b0 * 1536 + c)) * SEQ;
  const u16* v1p = hyT + ((size_t)(b1 * 1536 + c)) * SEQ;
  float* scr = (float*)(p.ws + WS_KC) + (size_t)blockIdx.x * 8192;
  __syncthreads();
#pragma unroll 4
  for (int i = 0; i < 8; ++i) {
    const int t = i * 512 + tid * 2;
    const unsigned a = *reinterpret_cast<const unsigned*>(v0p + t), bq = *reinterpret_cast<const unsigned*>(v1p + t);
    cf2 e0; e0.x = bflo(a); e0.y = bflo(bq); X[PADI(t)] = e0;
    cf2 e1; e1.x = bfhi(a); e1.y = bfhi(bq); X[PADI(t + 1)] = e1;
    cf2 zz; zz.x = 0.f; zz.y = 0.f; X[PADI(4096 + t)] = zz; X[PADI(4096 + t + 1)] = zz;
  }
  __syncthreads();
  hyena_conv_round<0>(p, X, c, b0, b1, scr);
  hyena_conv_round<1>(p, X, c, b0, b1, scr);
}

constexpr int KLD = 104, VLD = 72;
DEV unsigned cvtpk(float lo, float hi) { unsigned r; asm volatile("v_cvt_pk_bf16_f32 %0, %1, %2" : "=v"(r) : "v"(lo), "v"(hi)); return r; }
DEV void attention_item(const Params& p, int item, char* smem) {
  const int qb = item & 31, h = (item >> 5) & 7, b = item >> 8;
  const int tid = threadIdx.x, lane = tid & 63, w = tid >> 6, r32 = lane & 31, hi = lane >> 5;
  u16* Ks = (u16*)smem; u16* Vs = Ks + 64 * KLD;
  float* wsf = (float*)(Vs + 64 * VLD) + w * 32;
  const u16* qraw = (const u16*)(p.ws + WS_QRAW);
  const u16* kn = (const u16*)(p.ws + WS_KN);
  const u16* kpe = (const u16*)(p.ws + WS_KPE);
  const u16* vt = (const u16*)(p.ws + WS_VT) + ((size_t)((b * 8 + h) * 64)) * SEQ;
  constexpr float SC = 0.10206207261596577f * 1.4426950408889634f;
  const int tq = qb * 128 + w * 32 + r32;
  bf16x8 qr[6];
  {
    const u16* qp = qraw + ((size_t)(b * SEQ + tq)) * 768 + h * 96 + hi * 8;
#pragma unroll
    for (int d0 = 0; d0 < 6; ++d0) qr[d0] = *reinterpret_cast<const bf16x8*>(qp + d0 * 16);
    const float* ct = (const float*)(p.ws + WS_ROPE) + tq * 16 + hi * 8;
    const float* st = ct + 4096 * 16;
#pragma unroll
    for (int j = 0; j < 8; ++j) {
      const float x1 = bf2f((u16)qr[4][j]), x2 = bf2f((u16)qr[5][j]);
      const float c = ct[j], sn = st[j];
      qr[4][j] = (short)f2bf(x1 * c - x2 * sn);
      qr[5][j] = (short)f2bf(x1 * sn + x2 * c);
    }
  }
  f32x16 o0 = {}, o1 = {};
  float m_reg = -1e30f, l_reg = 0.f;
  const u16* ksrc[3]; int kstep[3], kdst[3];
#pragma unroll
  for (int i = 0; i < 3; ++i) {
    const int ch = tid + 256 * i, key = ch / 12, cc = ch - key * 12;
    const size_t tk = (size_t)(b * SEQ + key);
    ksrc[i] = (cc < 8) ? (kn + tk * 512 + h * 64 + cc * 8) : (kpe + tk * 32 + (cc - 8) * 8);
    kstep[i] = (cc < 8) ? 64 * 512 : 64 * 32;
    kdst[i] = key * KLD + cc * 8;
  }
  const u16* vsrc[2]; int vdst[2];
#pragma unroll
  for (int i = 0; i < 2; ++i) {
    const int ch = tid + 256 * i, dv = ch >> 3, cc = ch & 7;
    vsrc[i] = vt + (size_t)dv * SEQ + cc * 8;
    vdst[i] = dv * VLD + cc * 8;
  }
  u32x4 kreg[3], vreg[2];
#pragma unroll
  for (int i = 0; i < 3; ++i) kreg[i] = *reinterpret_cast<const u32x4*>(ksrc[i]);
#pragma unroll
  for (int i = 0; i < 2; ++i) vreg[i] = *reinterpret_cast<const u32x4*>(vsrc[i]);
  for (int k0 = 0; k0 < SEQ; k0 += 64) {
    __syncthreads();
#pragma unroll
    for (int i = 0; i < 3; ++i) *reinterpret_cast<u32x4*>(Ks + kdst[i]) = kreg[i];
#pragma unroll
    for (int i = 0; i < 2; ++i) *reinterpret_cast<u32x4*>(Vs + vdst[i]) = vreg[i];
    __syncthreads();
    if (k0 + 64 < SEQ) {
#pragma unroll
      for (int i = 0; i < 3; ++i) { ksrc[i] += kstep[i]; kreg[i] = *reinterpret_cast<const u32x4*>(ksrc[i]); }
#pragma unroll
      for (int i = 0; i < 2; ++i) { vsrc[i] += 64; vreg[i] = *reinterpret_cast<const u32x4*>(vsrc[i]); }
    }
    f32x16 p0 = {}, p1 = {};
    __builtin_amdgcn_s_setprio(1);
#pragma unroll
    for (int d0 = 0; d0 < 6; ++d0) {
      const bf16x8 k0f = *reinterpret_cast<const bf16x8*>(Ks + r32 * KLD + d0 * 16 + hi * 8);
      const bf16x8 k1f = *reinterpret_cast<const bf16x8*>(Ks + (32 + r32) * KLD + d0 * 16 + hi * 8);
      p0 = __builtin_amdgcn_mfma_f32_32x32x16_bf16(k0f, qr[d0], p0, 0, 0, 0);
      p1 = __builtin_amdgcn_mfma_f32_32x32x16_bf16(k1f, qr[d0], p1, 0, 0, 0);
    }
    __builtin_amdgcn_s_setprio(0);
    float pmax = p0[0];
#pragma unroll
    for (int r = 1; r < 16; ++r) pmax = fmaxf(pmax, p0[r]);
#pragma unroll
    for (int r = 0; r < 16; ++r) pmax = fmaxf(pmax, p1[r]);
    { const auto rr = __builtin_amdgcn_permlane32_swap(__float_as_uint(pmax), __float_as_uint(pmax), false, false);
      pmax = fmaxf(__uint_as_float(rr[0]), __uint_as_float(rr[1])); }
    const float mn = fmaxf(m_reg, pmax);
    const float alpha = __builtin_amdgcn_exp2f((m_reg - mn) * SC);
    m_reg = mn;
    const float mnC = -mn * SC;
    float ps = 0.f;
#pragma unroll
    for (int r = 0; r < 16; ++r) { p0[r] = __builtin_amdgcn_exp2f(fmaf(p0[r], SC, mnC)); ps += p0[r]; }
#pragma unroll
    for (int r = 0; r < 16; ++r) { p1[r] = __builtin_amdgcn_exp2f(fmaf(p1[r], SC, mnC)); ps += p1[r]; }
    l_reg = l_reg * alpha + ps;
    if (__any(alpha < 1.f)) {
      if (hi == 0) wsf[r32] = alpha;
      LGKM0();
#pragma unroll
      for (int r = 0; r < 16; ++r) { const float a = wsf[crow(r, hi)]; o0[r] *= a; o1[r] *= a; }
    }
    bf16x8 pa0, pa1, pa2, pa3;
#define PK4(P, BASE, OUT) do { unsigned a0 = cvtpk(P[BASE + 0], P[BASE + 1]), a1 = cvtpk(P[BASE + 2], P[BASE + 3]);   \
    unsigned b0 = cvtpk(P[BASE + 4], P[BASE + 5]), b1 = cvtpk(P[BASE + 6], P[BASE + 7]);                              \
    auto r0 = __builtin_amdgcn_permlane32_swap(a0, b0, false, false); auto r1 = __builtin_amdgcn_permlane32_swap(a1, b1, false, false); \
    u32x4 wv = {r0[0], r1[0], r0[1], r1[1]}; OUT = *reinterpret_cast<bf16x8*>(&wv); } while (0)
    PK4(p0, 0, pa0); PK4(p0, 8, pa1); PK4(p1, 0, pa2); PK4(p1, 8, pa3);
#undef PK4
    {
      const u16* vb0 = Vs + r32 * VLD + hi * 8;
      const u16* vb1 = Vs + (32 + r32) * VLD + hi * 8;
      __builtin_amdgcn_s_setprio(1);
      o0 = __builtin_amdgcn_mfma_f32_32x32x16_bf16(pa0, *reinterpret_cast<const bf16x8*>(vb0), o0, 0, 0, 0);
      o1 = __builtin_amdgcn_mfma_f32_32x32x16_bf16(pa0, *reinterpret_cast<const bf16x8*>(vb1), o1, 0, 0, 0);
      o0 = __builtin_amdgcn_mfma_f32_32x32x16_bf16(pa1, *reinterpret_cast<const bf16x8*>(vb0 + 16), o0, 0, 0, 0);
      o1 = __builtin_amdgcn_mfma_f32_32x32x16_bf16(pa1, *reinterpret_cast<const bf16x8*>(vb1 + 16), o1, 0, 0, 0);
      o0 = __builtin_amdgcn_mfma_f32_32x32x16_bf16(pa2, *reinterpret_cast<const bf16x8*>(vb0 + 32), o0, 0, 0, 0);
      o1 = __builtin_amdgcn_mfma_f32_32x32x16_bf16(pa2, *reinterpret_cast<const bf16x8*>(vb1 + 32), o1, 0, 0, 0);
      o0 = __builtin_amdgcn_mfma_f32_32x32x16_bf16(pa3, *reinterpret_cast<const bf16x8*>(vb0 + 48), o0, 0, 0, 0);
      o1 = __builtin_amdgcn_mfma_f32_32x32x16_bf16(pa3, *reinterpret_cast<const bf16x8*>(vb1 + 48), o1, 0, 0, 0);
      __builtin_amdgcn_s_setprio(0);
    }
    LGKM0();
  }
  l_reg += __shfl_xor(l_reg, 32);
  if (hi == 0) wsf[r32] = l_reg;
  LGKM0();
  const float g0 = p.in[I_AOG][h * 64 + r32], g1 = p.in[I_AOG][h * 64 + 32 + r32];
  u16* cat = (u16*)(p.ws + WS_CAT);
#pragma unroll
  for (int r = 0; r < 16; ++r) {
    const int row = crow(r, hi);
    const float il = 1.0f / wsf[row];
    const float a0 = o0[r] * il, a1 = o1[r] * il;
    float ss = a0 * a0 + a1 * a1;
#pragma unroll
    for (int off = 16; off >= 1; off >>= 1) ss += __shfl_xor(ss, off);
    const float rs = rsqrtf(ss * (1.f / 64.f) + RMS_EPS);
    u16* dst = cat + ((size_t)(b * SEQ + qb * 128 + w * 32 + row)) * 1024 + h * 64;
    dst[r32] = f2bf(a0 * rs * g0);
    dst[32 + r32] = f2bf(a1 * rs * g1);
  }
  LGKM0();
}
DEV void hyout_tile(const Params& p, int item, char* smem) {
  const int g = item & 7, tb = (item >> 3) & 63, b = item >> 9;
  const int tid = threadIdx.x, t0 = tb * 64;
  float* tile = (float*)smem;
  const u16* yT = (const u16*)(p.ws + WS_YT);
  __syncthreads();
#pragma unroll
  for (int i = 0; i < 2; ++i) {
    const int ch = tid + 256 * i, c = ch >> 3, cc = ch & 7;
    const u32x4 w = *reinterpret_cast<const u32x4*>(yT + ((size_t)(b * 512 + g * 64 + c)) * SEQ + t0 + cc * 8);
    float* d = tile + c * 65 + cc * 8;
#pragma unroll
    for (int j = 0; j < 4; ++j) { d[2 * j] = bflo(w[j]); d[2 * j + 1] = bfhi(w[j]); }
  }
  __syncthreads();
  const int t = tid >> 2, cq = (tid & 3) * 16;
  float v[16]; float ss = 0;
#pragma unroll
  for (int j = 0; j < 16; ++j) { v[j] = tile[(cq + j) * 65 + t]; ss += v[j] * v[j]; }
  ss += __shfl_xor(ss, 1); ss += __shfl_xor(ss, 2);
  const float rs = rsqrtf(ss * (1.f / 64.f) + RMS_EPS);
  const float* gg = p.in[I_HOG] + g * 64 + cq;
  unsigned o[8];
#pragma unroll
  for (int j = 0; j < 8; ++j) o[j] = pack2(v[2 * j] * rs * gg[2 * j], v[2 * j + 1] * rs * gg[2 * j + 1]);
  u16* dst = (u16*)(p.ws + WS_CAT) + ((size_t)(b * SEQ + t0 + t)) * 1024 + 512 + g * 64 + cq;
  *reinterpret_cast<u32x4*>(dst) = u32x4{o[0], o[1], o[2], o[3]};
  *reinterpret_cast<u32x4*>(dst + 8) = u32x4{o[4], o[5], o[6], o[7]};
}

template <int NR>
DEV void ln_mix_rows(const Params& p, int row0) {
  const int lane = threadIdx.x & 63;
  float v[NR][16];
#pragma unroll
  for (int r = 0; r < NR; ++r) {
    const u16* hb = (const u16*)(p.ws + WS_HB) + (size_t)(row0 + r) * DM;
    const u16* mx = (const u16*)(p.ws + WS_MIX) + (size_t)(row0 + r) * DM;
#pragma unroll
    for (int i = 0; i < 2; ++i) {
      const int c = (i * 64 + lane) * 8;
      const u32x4 a = *reinterpret_cast<const u32x4*>(hb + c), m = *reinterpret_cast<const u32x4*>(mx + c);
#pragma unroll
      for (int j = 0; j < 4; ++j) { v[r][i * 8 + 2 * j] = ALPHA * bflo(a[j]) + bflo(m[j]); v[r][i * 8 + 2 * j + 1] = ALPHA * bfhi(a[j]) + bfhi(m[j]); }
    }
  }
  float mu[NR], rstd[NR];
#pragma unroll
  for (int r = 0; r < NR; ++r) {
    float s = 0;
#pragma unroll
    for (int j = 0; j < 16; ++j) s += v[r][j];
    mu[r] = wave_sum(s) * (1.f / DM);
  }
#pragma unroll
  for (int r = 0; r < NR; ++r) {
    float ss = 0;
#pragma unroll
    for (int j = 0; j < 16; ++j) { const float d = v[r][j] - mu[r]; ss += d * d; }
    rstd[r] = rsqrtf(wave_sum(ss) * (1.f / DM) + LN_EPS);
  }
#pragma unroll
  for (int i = 0; i < 2; ++i) {
    const int c = (i * 64 + lane) * 8;
    const float* g = p.in[I_LNMG] + c; const float* bb = p.in[I_LNMB] + c;
#pragma unroll
    for (int r = 0; r < NR; ++r) {
      u16* h2 = (u16*)(p.ws + WS_H2B) + (size_t)(row0 + r) * DM;
      unsigned o[4];
#pragma unroll
      for (int j = 0; j < 4; ++j) o[j] = pack2((v[r][i * 8 + 2 * j] - mu[r]) * rstd[r] * g[2 * j] + bb[2 * j], (v[r][i * 8 + 2 * j + 1] - mu[r]) * rstd[r] * g[2 * j + 1] + bb[2 * j + 1]);
      *reinterpret_cast<u32x4*>(h2 + c) = u32x4{o[0], o[1], o[2], o[3]};
    }
  }
}

constexpr int SC_LD = 353, SC_PP = 176, SC_PT = 40;
constexpr int TV_LD = 33, TI_LD = 36;
DEV void routing_group(const Params& p, int item, char* smem) {
  const int hg = item & 1, tt = item >> 1, t0 = tt * 32;
  const int tid = threadIdx.x, lane = tid & 63, w = tid >> 6, r32 = lane & 31, hi = lane >> 5;
  float* sc = (float*)smem;
  float* topv = sc + 32 * SC_LD;
  unsigned char* topi = (unsigned char*)(topv + 4 * 32 * TV_LD);
  const u16* pq = (const u16*)(p.ws + WS_PQ);
  const u16* subk = (const u16*)(p.ws + WS_SUBK);
#pragma unroll 1
  for (int hh = 0; hh < 4; ++hh) {
    const int h = hg * 4 + hh;
    __syncthreads();
    {
      const int pp = w >> 1, nt0 = (w & 1) * 2;
      f32x16 a0 = {}, a1 = {};
      const u16* ap = pq + ((size_t)(t0 + r32)) * 1024 + h * 128 + pp * 64 + hi * 8;
      const u16* bp0 = subk + ((size_t)((h * 2 + pp) * 128 + nt0 * 32 + r32)) * 64 + hi * 8;
      const u16* bp1 = bp0 + 32 * 64;
#pragma unroll
      for (int kk = 0; kk < 4; ++kk) {
        const bf16x8 a = *reinterpret_cast<const bf16x8*>(ap + kk * 16);
        const bf16x8 b0 = *reinterpret_cast<const bf16x8*>(bp0 + kk * 16);
        const bf16x8 b1 = *reinterpret_cast<const bf16x8*>(bp1 + kk * 16);
        a0 = __builtin_amdgcn_mfma_f32_32x32x16_bf16(a, b0, a0, 0, 0, 0);
        a1 = __builtin_amdgcn_mfma_f32_32x32x16_bf16(a, b1, a1, 0, 0, 0);
      }
#pragma unroll
      for (int r = 0; r < 16; ++r) {
        const int tok = crow(r, hi);
        sc[tok * SC_LD + pp * SC_PP + nt0 * SC_PT + r32] = a0[r];
        sc[tok * SC_LD + pp * SC_PP + (nt0 + 1) * SC_PT + r32] = a1[r];
      }
    }
    __syncthreads();
    {
      const int tok = w * 8 + (lane & 7), pp = (lane >> 3) & 1, part = lane >> 4;
      float* row = sc + tok * SC_LD + pp * SC_PP;
      float* tv = topv + (hh * 32 + tok) * TV_LD + pp * 16;
      unsigned char* ti = topi + (hh * 32 + tok) * TI_LD + pp * 16;
      for (int rd = 0; rd < 16; ++rd) {
        float bv = -INFINITY; int bi = part * 32;
        float sv[32];
#pragma unroll
        for (int n = 0; n < 32; ++n) sv[n] = row[part * SC_PT + n];
#pragma unroll
        for (int n = 0; n < 32; ++n) { if (sv[n] > bv) { bv = sv[n]; bi = part * 32 + n; } }
#pragma unroll
        for (int off = 16; off <= 32; off <<= 1) {
          const float ov = __shfl_xor(bv, off); const int oi = __shfl_xor(bi, off);
          if (ov > bv || (ov == bv && oi < bi)) { bv = ov; bi = oi; }
        }
        if ((bi >> 5) == part) row[part * SC_PT + (bi & 31)] = -INFINITY;
        if (part == 0) { tv[rd] = bv; ti[rd] = (unsigned char)bi; }
      }
    }
  }
  __syncthreads();
  if (tid < 128) {
    const int tok = tid & 31, hh = tid >> 5, h = hg * 4 + hh;
    const float* s0 = topv + (hh * 32 + tok) * TV_LD; const float* s1 = s0 + 16;
    const unsigned char* i0 = topi + (hh * 32 + tok) * TI_LD; const unsigned char* i1 = i0 + 16;
    unsigned long long ptr = 0ull;
    float s0r[16];
#pragma unroll
    for (int i = 0; i < 16; ++i) s0r[i] = s0[i];
    float best[16]; int be[16];
#pragma unroll
    for (int rd = 0; rd < 16; ++rd) {
      float bv = -INFINITY; int bi = 0, bj = 0;
      float s1v[16];
#pragma unroll
      for (int i = 0; i < 16; ++i) s1v[i] = s1[(int)((ptr >> (4 * i)) & 15ull)];
#pragma unroll
      for (int i = 0; i < 16; ++i) {
        const int j = (int)((ptr >> (4 * i)) & 15ull);
        const float v = s0r[i] + s1v[i];
        if (v > bv) { bv = v; bi = i; bj = j; }
      }
      ptr += 1ull << (4 * bi);
      best[rd] = bv; be[rd] = (int)i0[bi] * 128 + (int)i1[bj];
    }
    const float mx = best[0];
    float sum = 0.f;
#pragma unroll
    for (int rd = 0; rd < 16; ++rd) { best[rd] = expf(best[rd] - mx); sum += best[rd]; }
    const float inv = 1.0f / sum;
    int* eo = (int*)(p.ws + WS_EIDX) + ((size_t)(t0 + tok)) * 128 + h * 16;
    float* go = (float*)(p.ws + WS_GATE) + ((size_t)(t0 + tok)) * 128 + h * 16;
#pragma unroll
    for (int c4 = 0; c4 < 4; ++c4) {
      *reinterpret_cast<u32x4*>(eo + c4 * 4) = u32x4{(unsigned)be[c4 * 4], (unsigned)be[c4 * 4 + 1], (unsigned)be[c4 * 4 + 2], (unsigned)be[c4 * 4 + 3]};
      *reinterpret_cast<f32x4*>(go + c4 * 4) = f32x4{best[c4 * 4] * inv, best[c4 * 4 + 1] * inv, best[c4 * 4 + 2] * inv, best[c4 * 4 + 3] * inv};
    }
  }
}

DEV void peer_u(const Params& p, int t) {
  const int tid = threadIdx.x, lane = tid & 63, w = tid >> 6, q = lane & 15, rr = lane >> 4;
  const u16* x = (const u16*)(p.ws + WS_H2B) + (size_t)t * DM;
  const unsigned char* ub = (const unsigned char*)(p.ws + WS_UB);
  float xf[64];
#pragma unroll
  for (int i = 0; i < 4; ++i) {
    const u32x4 a = *reinterpret_cast<const u32x4*>(x + (i * 16 + q) * 16), b = *reinterpret_cast<const u32x4*>(x + (i * 16 + q) * 16 + 8);
#pragma unroll
    for (int j = 0; j < 4; ++j) { xf[i * 16 + 2 * j] = bflo(a[j]); xf[i * 16 + 2 * j + 1] = bfhi(a[j]); xf[i * 16 + 8 + 2 * j] = bflo(b[j]); xf[i * 16 + 8 + 2 * j + 1] = bfhi(b[j]); }
  }
  const int* ei = (const int*)(p.ws + WS_EIDX) + (size_t)t * 128;
  float* gi = (float*)(p.ws + WS_GATE) + (size_t)t * 128;
  const int e_lo = ei[lane], e_hi = ei[64 + lane];
  const float g_lo = gi[lane], g_hi = gi[64 + lane];
#pragma unroll 1
  for (int it = 0; it < 16; ++it) {
    const int k0 = it * 8 + rr, k1 = k0 + 4;
    const int e0 = (it < 8) ? __shfl(e_lo, k0) : __shfl(e_hi, k0 - 64);
    const int e1 = (it < 8) ? __shfl(e_lo, k1) : __shfl(e_hi, k1 - 64);
    const float g0 = (it < 8) ? __shfl(g_lo, k0) : __shfl(g_hi, k0 - 64);
    const float g1 = (it < 8) ? __shfl(g_lo, k1) : __shfl(g_hi, k1 - 64);
    const unsigned char* r0 = ub + (size_t)e0 * DM + q * 16;
    const unsigned char* r1 = ub + (size_t)e1 * DM + q * 16;
    u32x4 u0[4], u1[4];
#pragma unroll
    for (int i = 0; i < 4; ++i) { u0[i] = *reinterpret_cast<const u32x4*>(r0 + i * 256); u1[i] = *reinterpret_cast<const u32x4*>(r1 + i * 256); }
    float a0 = 0.f, a1 = 0.f, c0 = 0.f, c1 = 0.f;
#pragma unroll
    for (int i = 0; i < 4; ++i) {
#pragma unroll
      for (int d = 0; d < 4; ++d) {
        const f32x2 lo0 = __builtin_amdgcn_cvt_pk_f32_fp8((int)u0[i][d], false), hi0 = __builtin_amdgcn_cvt_pk_f32_fp8((int)u0[i][d], true);
        const f32x2 lo1 = __builtin_amdgcn_cvt_pk_f32_fp8((int)u1[i][d], false), hi1 = __builtin_amdgcn_cvt_pk_f32_fp8((int)u1[i][d], true);
        const int xb = i * 16 + d * 4;
        a0 = fmaf(lo0[0], xf[xb], a0); a1 = fmaf(lo0[1], xf[xb + 1], a1); a0 = fmaf(hi0[0], xf[xb + 2], a0); a1 = fmaf(hi0[1], xf[xb + 3], a1);
        c0 = fmaf(lo1[0], xf[xb], c0); c1 = fmaf(lo1[1], xf[xb + 1], c1); c0 = fmaf(hi1[0], xf[xb + 2], c0); c1 = fmaf(hi1[1], xf[xb + 3], c1);
      }
    }
    float a = a0 + a1, c = c0 + c1;
    a += __shfl_xor(a, 1); c += __shfl_xor(c, 1);
    a += __shfl_xor(a, 2); c += __shfl_xor(c, 2);
    a += __shfl_xor(a, 4); c += __shfl_xor(c, 4);
    a += __shfl_xor(a, 8); c += __shfl_xor(c, 8);
    a *= (1.f / 128.f); c *= (1.f / 128.f);
    const float ga = 0.5f * a * (1.0f + erff(a * 0.7071067811865476f));
    const float gc = 0.5f * c * (1.0f + erff(c * 0.7071067811865476f));
    if (q == 0) { gi[k0] = g0 * ga * (1.f / 16.f); gi[k1] = g1 * gc * (1.f / 16.f); }
  }
}
DEV void peer_v(const Params& p, int t) {
  const int lane = threadIdx.x & 63;
  const u16* x = (const u16*)(p.ws + WS_H2B) + (size_t)t * DM;
  const unsigned char* vb = (const unsigned char*)(p.ws + WS_VB);
  const int* ei = (const int*)(p.ws + WS_EIDX) + (size_t)t * 128;
  const float* gi = (const float*)(p.ws + WS_GATE) + (size_t)t * 128;
  const int e_lo = ei[lane], e_hi = ei[64 + lane];
  const float w_lo = gi[lane], w_hi = gi[64 + lane];
  float acc[16];
#pragma unroll
  for (int j = 0; j < 16; ++j) acc[j] = 0.f;
#pragma unroll 1
  for (int k = 0; k < 128; k += 16) {
    u32x4 vv[16]; float wk[16];
#pragma unroll
    for (int kk = 0; kk < 16; ++kk) {
      const int kx = k + kk;
      const int e = (kx < 64) ? __shfl(e_lo, kx) : __shfl(e_hi, kx - 64);
      vv[kk] = *reinterpret_cast<const u32x4*>(vb + (size_t)e * DM + lane * 16);
      wk[kk] = (kx < 64) ? __shfl(w_lo, kx) : __shfl(w_hi, kx - 64);
    }
#pragma unroll
    for (int kk = 0; kk < 16; ++kk) {
#pragma unroll
      for (int d = 0; d < 4; ++d) {
        const f32x2 lo = __builtin_amdgcn_cvt_pk_f32_fp8((int)vv[kk][d], false), hi = __builtin_amdgcn_cvt_pk_f32_fp8((int)vv[kk][d], true);
        acc[d * 4 + 0] = fmaf(wk[kk], lo[0], acc[d * 4 + 0]); acc[d * 4 + 1] = fmaf(wk[kk], lo[1], acc[d * 4 + 1]);
        acc[d * 4 + 2] = fmaf(wk[kk], hi[0], acc[d * 4 + 2]); acc[d * 4 + 3] = fmaf(wk[kk], hi[1], acc[d * 4 + 3]);
      }
    }
  }
  float y[16];
  {
    const u32x4 ha = *reinterpret_cast<const u32x4*>(x + lane * 16), hb2 = *reinterpret_cast<const u32x4*>(x + lane * 16 + 8);
#pragma unroll
    for (int j = 0; j < 4; ++j) {
      y[2 * j] = ALPHA * bflo(ha[j]) + acc[2 * j]; y[2 * j + 1] = ALPHA * bfhi(ha[j]) + acc[2 * j + 1];
      y[8 + 2 * j] = ALPHA * bflo(hb2[j]) + acc[8 + 2 * j]; y[8 + 2 * j + 1] = ALPHA * bfhi(hb2[j]) + acc[8 + 2 * j + 1];
    }
  }
  float s = 0;
#pragma unroll
  for (int j = 0; j < 16; ++j) s += y[j];
  const float mu = wave_sum(s) * (1.f / DM);
  float ss = 0;
#pragma unroll
  for (int j = 0; j < 16; ++j) { const float d = y[j] - mu; ss += d * d; }
  const float rstd = rsqrtf(wave_sum(ss) * (1.f / DM) + LN_EPS);
  float* outp = p.out + (size_t)t * DM + lane * 16;
  const float* g = p.in[I_LNFG] + lane * 16; const float* bb = p.in[I_LNFB] + lane * 16;
#pragma unroll
  for (int c4 = 0; c4 < 4; ++c4) {
    f32x4 o;
#pragma unroll
    for (int j = 0; j < 4; ++j) o[j] = (y[c4 * 4 + j] - mu) * rstd * g[c4 * 4 + j] + bb[c4 * 4 + j];
    *reinterpret_cast<f32x4*>(outp + c4 * 4) = o;
  }
}

#define XB_TMO      128
#define XB_XCNT(j)  (256  + 64 * (j))
#define XB_XSUB(j)  (1280 + 64 * (j))
#define XB_XGEN(j)  (2304 + 64 * (j))
#define XB_TOP      3328
#define XB_TOPGEN   3392
#define XCD_BAR_WORDS 3456
#define XB_SPIN_CAP (1u << 18)
#define LAS __attribute__((address_space(3)))

__device__ __forceinline__ unsigned xb_ld(unsigned* p)              { return __hip_atomic_load(p, __ATOMIC_RELAXED, __HIP_MEMORY_SCOPE_AGENT); }
__device__ __forceinline__ unsigned xb_add(unsigned* p, unsigned v) { return __hip_atomic_fetch_add(p, v, __ATOMIC_RELAXED, __HIP_MEMORY_SCOPE_AGENT); }
#define XB_SPIN(cond, bar) do { unsigned _sp = 0; while (cond) { __builtin_amdgcn_s_sleep(1); \
    if ((++_sp & 255u) == 0u) { if (xb_ld(&(bar)[XB_TMO])) break; if (_sp > XB_SPIN_CAP) { atomicAdd(&(bar)[XB_TMO], 1u); break; } } } } while (0)

struct XcdBarrier {
    unsigned* bar; unsigned x;
    volatile unsigned* st;
};

__device__ __forceinline__ XcdBarrier xcd_barrier_post(unsigned* bar, volatile unsigned* st) {
    XcdBarrier b; b.bar = bar; b.x = xcc_id(); b.st = st;
    if (threadIdx.x == 0) (void)xb_add(&bar[XB_XCNT(b.x)], 1u);
    return b;
}
__device__ __forceinline__ void xcd_barrier_complete(unsigned* bar, unsigned x, unsigned& nloc, unsigned& nx) {
    const unsigned G = gridDim.x * gridDim.y * gridDim.z;
    unsigned sum, cnt, mine, sp = 0u;
    for (;;) {
        sum = 0u; cnt = 0u; mine = 0u;
#pragma unroll
        for (unsigned j = 0; j < 16; ++j) { const unsigned c = xb_ld(&bar[XB_XCNT(j)]); sum += c; cnt += (c > 0u) ? 1u : 0u; mine = (j == x) ? c : mine; }
        if (sum == G) break;
        __builtin_amdgcn_s_sleep(1);
        if ((++sp & 255u) == 0u) { if (xb_ld(&bar[XB_TMO])) break; if (sp > XB_SPIN_CAP) { atomicAdd(&bar[XB_TMO], 1u); break; } }
    }
    nloc = mine > 0u ? mine : 1u; nx = cnt > 0u ? cnt : 1u;
}

__device__ __forceinline__ void xcd_barrier(const XcdBarrier& b) {
    asm volatile("s_waitcnt vmcnt(0)" ::: "memory");
    __syncthreads();
    if (threadIdx.x == 0) {
        unsigned* bar = b.bar;
        __builtin_amdgcn_s_waitcnt(0);
        unsigned nloc = b.st[0], nx = b.st[1];
        if (nloc == 0u) { xcd_barrier_complete(bar, b.x, nloc, nx); b.st[0] = nloc; b.st[1] = nx; }
        const unsigned old = xb_add(&bar[XB_XSUB(b.x)], 1u);
        const unsigned gen = old / nloc;
        if (old + 1u == (gen + 1u) * nloc) {
            __builtin_amdgcn_fence(__ATOMIC_RELEASE, "agent");
            asm volatile("s_waitcnt vmcnt(0)" ::: "memory");
            const unsigned og = xb_add(&bar[XB_TOP], 1u);
            const unsigned tg = og / nx;
            if (og + 1u == (tg + 1u) * nx) xb_add(&bar[XB_TOPGEN], 1u);
            else XB_SPIN(xb_ld(&bar[XB_TOPGEN]) == tg, bar);
            __builtin_amdgcn_fence(__ATOMIC_ACQUIRE, "agent");
            xb_add(&bar[XB_XGEN(b.x)], 1u);
            asm volatile("s_waitcnt vmcnt(0)" ::: "memory");
        } else {
            XB_SPIN(xb_ld(&bar[XB_XGEN(b.x)]) == gen, bar);
            __builtin_amdgcn_fence(__ATOMIC_ACQUIRE, "agent");
            asm volatile("s_waitcnt vmcnt(0)" ::: "memory");
        }
    }
    __syncthreads();
}


constexpr int NPHASES = 11;
template <int ph> DEV void run_phase(const Params& p, char* smem, bool leader) {
  const int bid = blockIdx.x, nb = gridDim.x, tid = threadIdx.x, w = tid >> 6;
  const int gtid = bid * NTHREADS + tid, gsize = nb * NTHREADS;
  {
    if constexpr (ph == 0) {
      for (int it = bid; it < NT / 16; it += nb) ln_x_rows<4>(p, (it * 4 + w) * 4);
      transpose_cvt(p.in[I_WIN], (u16*)(p.ws + WS_WIN), 1024, INW, gtid, gsize);
      transpose_cvt(p.in[I_WUQ], (u16*)(p.ws + WS_WUQ), 256, 768, gtid, gsize);
      transpose_cvt(p.in[I_WUKV], (u16*)(p.ws + WS_WUKV), 128, 1024, gtid, gsize);
      transpose_cvt(p.in[I_WO], (u16*)(p.ws + WS_WO), 1024, 1024, gtid, gsize);
      transpose_cvt(p.in[I_PWQ], (u16*)(p.ws + WS_WQ), 1024, 1024, gtid, gsize);
      cvt_bf16(p.in[I_PSK], (u16*)(p.ws + WS_SUBK), 8 * 2 * 128 * 64 / 8, gtid, gsize);
      cvt_fp8(p.in[I_PU], (unsigned char*)(p.ws + WS_UB), (size_t)16384 * 1024 / 16, 128.f, gtid, gsize);
      cvt_fp8(p.in[I_PV], (unsigned char*)(p.ws + WS_VB), (size_t)16384 * 1024 / 16, 16.f, gtid, gsize);
      rope_table(p, gtid, gsize);
      for (int it = bid; it < 4096 / 4; it += nb) hy_hidden(p, it * 4 + w);
    }
    if constexpr (ph == 1) {
      for (int it = bid; it < 1024; it += nb) filter_build(p, it, smem);
      EpiBf16 epi{(u16*)(p.ws + WS_RA), PLD, INW};
      if (nb == 512) {
        const int xcd = bid & 7, local = bid >> 3, g = local >> 4, ntile = local & 15;
        for (int j = 0; j < 16; ++j)
          gemm_tile((const u16*)(p.ws + WS_HB), DM, (const u16*)(p.ws + WS_WIN), DM, INW, DM, ((xcd * 4 + g) + 32 * j) * 128, ntile * 128, epi, smem);
      } else
      for (int it = bid; it < 512 * 16; it += nb)
        gemm_tile((const u16*)(p.ws + WS_HB), DM, (const u16*)(p.ws + WS_WIN), DM, INW, DM, (it >> 4) * 128, (it & 15) * 128, epi, smem);
    }
    if constexpr (ph == 2) {
      int* q = (int*)(p.ws + WS_CTRL) + 3 * 4096;
      for (int it = next_item(q + 0, smem); it < 1024; it = next_item(q + 0, smem)) kspec_item(p, it, smem);
      for (int it = bid; it < NT / 4; it += nb) token_norms(p, it * 4 + w);
      for (int it = bid; it < NB * 64 * 24; it += nb) shortconv_tile(p, it, smem);
    }
    if constexpr (ph == 3) {
      int* q = (int*)(p.ws + WS_CTRL) + 3 * 4096;
      for (int it = next_item(q + 1, smem); it < 4096; it = next_item(q + 1, smem)) hyena_conv_item(p, it, smem);
      EpiBf16 epiq{(u16*)(p.ws + WS_QRAW), 768, 768};
      EpiKV epikv{(u16*)(p.ws + WS_KN), (u16*)(p.ws + WS_VT)};
      for (int it = next_item(q + 2, smem); it < 512 * 14; it = next_item(q + 2, smem)) {
        if (it < 512 * 6)
          gemm_tile((const u16*)(p.ws + WS_CQN), 256, (const u16*)(p.ws + WS_WUQ), 256, 768, 256, (it / 6) * 128, (it % 6) * 128, epiq, smem);
        else {
          const int i2 = it - 512 * 6;
          gemm_tile((const u16*)(p.ws + WS_CKVN), 128, (const u16*)(p.ws + WS_WUKV), 128, 1024, 128, (i2 >> 3) * 128, (i2 & 7) * 128, epikv, smem);
        }
      }
    }
    if constexpr (ph == 4) {
      if (nb == 512) {
        const int xcd = bid & 7, local = bid >> 3, ps = local >> 5, qb = local & 31;
        for (int j = 0; j < 8; ++j) attention_item(p, ((xcd * 2 + ps) + 16 * j) * 32 + qb, smem);
      } else
      for (int it = bid; it < 4096; it += nb) attention_item(p, it, smem);
      for (int it = bid; it < NB * 64 * 8; it += nb) hyout_tile(p, it, smem);
    }
    if constexpr (ph == 5) {
      EpiBf16 epi{(u16*)(p.ws + WS_MIX), DM, DM};
      if (nb == 512) {
        const int xcd = bid & 7, local = bid >> 3, g = local >> 3, ntile = local & 7;
        for (int j = 0; j < 8; ++j)
          gemm_tile((const u16*)(p.ws + WS_CAT), DM, (const u16*)(p.ws + WS_WO), DM, DM, DM, ((xcd * 8 + g) + 64 * j) * 128, ntile * 128, epi, smem);
      } else
      for (int it = bid; it < 512 * 8; it += nb)
        gemm_tile((const u16*)(p.ws + WS_CAT), DM, (const u16*)(p.ws + WS_WO), DM, DM, DM, (it >> 3) * 128, (it & 7) * 128, epi, smem);
    }
    if constexpr (ph == 6) {
      for (int it = bid; it < NT / 16; it += nb) ln_mix_rows<4>(p, (it * 4 + w) * 4);
    }
    if constexpr (ph == 7) {
      EpiBf16 epi{(u16*)(p.ws + WS_PQ), DM, DM};
      if (nb == 512) {
        const int xcd = bid & 7, local = bid >> 3, g = local >> 3, ntile = local & 7;
        for (int j = 0; j < 8; ++j)
          gemm_tile((const u16*)(p.ws + WS_H2B), DM, (const u16*)(p.ws + WS_WQ), DM, DM, DM, ((xcd * 8 + g) + 64 * j) * 128, ntile * 128, epi, smem);
      } else
      for (int it = bid; it < 512 * 8; it += nb)
        gemm_tile((const u16*)(p.ws + WS_H2B), DM, (const u16*)(p.ws + WS_WQ), DM, DM, DM, (it >> 3) * 128, (it & 7) * 128, epi, smem);
    }
    if constexpr (ph == 8) {
      for (int it = bid; it < NT / 32; it += nb)
        for (int hg = 0; hg < 2; ++hg) routing_group(p, it * 2 + hg, smem);
    }
    if constexpr (ph == 9) {
      for (int it = bid; it < NT / 4; it += nb) peer_u(p, it * 4 + w);
    }
    if constexpr (ph == 10) {
      for (int it = bid; it < NT / 4; it += nb) peer_v(p, it * 4 + w);
    }
  }
}

#if !MULTI_LAUNCH
__global__ void __launch_bounds__(NTHREADS, 2) __attribute__((target("no-packed-fp32-ops"))) mega_kernel(Params p) {
  extern __shared__ __attribute__((aligned(16))) char smem[];
  cg::grid_group grid = cg::this_grid();
  if (threadIdx.x == 0) { ((unsigned*)(smem + LDS_CTRL_OFF))[4] = 0u; ((unsigned*)(smem + LDS_CTRL_OFF))[5] = 0u; }
  __syncthreads();
  const XcdBarrier xb = xcd_barrier_post((unsigned*)(p.ws + WS_CTRL + CTRL_BAR_OFF), (volatile unsigned*)(smem + LDS_CTRL_OFF) + 4);
  int* shw = (int*)(smem + LDS_CTRL_OFF);
  if (threadIdx.x == 0) {
    int* slot = (int*)(p.ws + WS_CTRL);
    const int key = (int)(xcc_id() * 256 + cu_key());
    shw[2] = key;
    shw[0] = (atomicAdd(slot + key, 1) == 0) ? 1 : 0;
  }
  __syncthreads();
  const bool leader = shw[0] != 0;
  run_phase<0>(p, smem, leader); grid.sync();
  run_phase<1>(p, smem, leader); xcd_barrier(xb);
  run_phase<2>(p, smem, leader); xcd_barrier(xb);
  run_phase<3>(p, smem, leader); xcd_barrier(xb);
  run_phase<4>(p, smem, leader); xcd_barrier(xb);
  run_phase<5>(p, smem, leader); xcd_barrier(xb);
  run_phase<6>(p, smem, leader); xcd_barrier(xb);
  run_phase<7>(p, smem, leader); xcd_barrier(xb);
  run_phase<8>(p, smem, leader); xcd_barrier(xb);
  run_phase<9>(p, smem, leader); xcd_barrier(xb);
  run_phase<10>(p, smem, leader);
}
#endif
#ifndef DBG_PHASE
#define DBG_PHASE -1
#endif
__global__ void __launch_bounds__(NTHREADS) hash_kernel(Params p, size_t off, size_t n16, unsigned* word) {
  const u16* src = (const u16*)(p.ws + off);
  unsigned acc = 0;
  for (size_t j = (size_t)blockIdx.x * NTHREADS + threadIdx.x; j < n16; j += (size_t)gridDim.x * NTHREADS) {
    unsigned x = (unsigned)src[j] + 0x9e3779b9u * (unsigned)(j + 1);
    x ^= x >> 16; x *= 0x85ebca6bu; x ^= x >> 13; x *= 0xc2b2ae35u; x ^= x >> 16;
    acc += x;
  }
#pragma unroll
  for (int o = 32; o >= 1; o >>= 1) acc += __shfl_xor(acc, o);
  if ((threadIdx.x & 63) == 0) atomicAdd(word, acc);
}
__global__ void __launch_bounds__(NTHREADS) dump_kernel(Params p, const unsigned* word) {
  const size_t NOUT = (size_t)NT * DM;
  const unsigned w = *word;
  for (size_t i = (size_t)blockIdx.x * NTHREADS + threadIdx.x; i < NOUT; i += (size_t)gridDim.x * NTHREADS) {
    unsigned x = w + (unsigned)i * 0x9e3779b9u; x ^= x >> 16; x *= 0x85ebca6bu; x ^= x >> 13;
    p.out[i] = (float)(x & 0xffffu) * (1.f / 65536.f);
  }
}
#if MULTI_LAUNCH
template <int PH> __global__ void __launch_bounds__(NTHREADS, 2) phase_kernel(Params p) {
  extern __shared__ __attribute__((aligned(16))) char smem[];
  if (threadIdx.x == 0) ((int*)(smem + LDS_CTRL_OFF))[2] = 0;
  __syncthreads();
  run_phase<PH>(p, smem, true);
}
template <int PH> static void launch_phase(const Params& p, int grid, hipStream_t stream) {
  (void)hipFuncSetAttribute((const void*)phase_kernel<PH>, hipFuncAttributeMaxDynamicSharedMemorySize, LDS_BYTES);
  hipLaunchKernelGGL(phase_kernel<PH>, dim3(grid), dim3(NTHREADS), LDS_BYTES, stream, p);
}
#endif

extern "C" void kernel_launch(void* const* d_in, const int* in_sizes, int n_in, void* d_out, int out_size, void* d_ws, size_t ws_size, hipStream_t stream) {
  static int grid_blocks = 0;
  if (!grid_blocks) {
    int dev = 0, cus = 0, per_cu = 0;
    (void)hipGetDevice(&dev);
    (void)hipDeviceGetAttribute(&cus, hipDeviceAttributeMultiprocessorCount, dev);
#if !MULTI_LAUNCH
    (void)hipFuncSetAttribute((const void*)mega_kernel, hipFuncAttributeMaxDynamicSharedMemorySize, LDS_BYTES);
#endif
#if MULTI_LAUNCH
#endif
#if !MULTI_LAUNCH
    (void)hipOccupancyMaxActiveBlocksPerMultiprocessor(&per_cu, (const void*)mega_kernel, NTHREADS, LDS_BYTES);
#else
    per_cu = 2;
#endif
    if (per_cu > 2) per_cu = 2;
    if (per_cu < 1) per_cu = 1;
    grid_blocks = cus * per_cu;
    if (ws_size < WS_END) fprintf(stderr, "kernel_launch: workspace too small: %zu < %zu\n", ws_size, (size_t)WS_END);
  }
  Params p{};
  for (int i = 0; i < 29; ++i) p.in[i] = (const float*)d_in[i];
  p.out = (float*)d_out;
  p.ws = (char*)d_ws;
  (void)hipMemsetAsync((char*)d_ws + WS_CTRL, 0, CTRL_BYTES, stream);
#if MULTI_LAUNCH
  launch_phase<0>(p, grid_blocks, stream);
  if (DBG_PHASE < 0 || DBG_PHASE >= 1) launch_phase<1>(p, grid_blocks, stream);
  if (DBG_PHASE < 0 || DBG_PHASE >= 2) launch_phase<2>(p, grid_blocks, stream);
  if (DBG_PHASE < 0 || DBG_PHASE >= 3) launch_phase<3>(p, grid_blocks, stream);
  if (DBG_PHASE < 0 || DBG_PHASE >= 4) launch_phase<4>(p, grid_blocks, stream);
  if (DBG_PHASE < 0 || DBG_PHASE >= 5) launch_phase<5>(p, grid_blocks, stream);
  if (DBG_PHASE < 0 || DBG_PHASE >= 6) launch_phase<6>(p, grid_blocks, stream);
  if (DBG_PHASE < 0 || DBG_PHASE >= 7) launch_phase<7>(p, grid_blocks, stream);
  if (DBG_PHASE < 0 || DBG_PHASE >= 8) launch_phase<8>(p, grid_blocks, stream);
  if (DBG_PHASE < 0) launch_phase<9>(p, grid_blocks, stream);
  if (DBG_PHASE >= 0) {
    unsigned* word = (unsigned*)((char*)d_ws + WS_END + 65536);
    (void)hipMemsetAsync(word, 0, 4, stream);
    hipLaunchKernelGGL(hash_kernel, dim3(2048), dim3(NTHREADS), 0, stream, p, (size_t)DBG_OFF, (size_t)DBG_N16, word);
    hipLaunchKernelGGL(dump_kernel, dim3(2048), dim3(NTHREADS), 0, stream, p, (const unsigned*)word);
  }
#else
  void* args[] = {&p};
  hipError_t e = hipLaunchCooperativeKernel((const void*)mega_kernel, dim3(grid_blocks), dim3(NTHREADS), args, LDS_BYTES, stream);
  if (e != hipSuccess) fprintf(stderr, "cooperative launch failed: %s (grid %d)\n", hipGetErrorString(e), grid_blocks);
#endif
}
```
